# Optimizing an MI355X kernel written in HIP

```python
import math
import jax, jax.numpy as jnp
from jax import lax
import numpy as np

D_MODEL = 1024
BATCH = 4
SEQ = 8192
DEPTH = 2

HEAD_DIM = 64
N_Q_HEADS = 8
N_KV_HEADS = 2
GQA_GROUP = N_Q_HEADS // N_KV_HEADS
ATTN_WIDTH = N_Q_HEADS * HEAD_DIM
KV_WIDTH = N_KV_HEADS * HEAD_DIM
N_CONV_GROUPS = 8
CONV_WIDTH = N_CONV_GROUPS * HEAD_DIM
MIX_WIDTH = ATTN_WIDTH + CONV_WIDTH
CONV_K = 3
WINDOW = 128
BLOCK = 128
D_FF = 2816
NORM_EPS = 1e-6

Q_END = ATTN_WIDTH
K_END = Q_END + KV_WIDTH
V_END = K_END + KV_WIDTH
CB_END = V_END + CONV_WIDTH
CC_END = CB_END + CONV_WIDTH
CH_END = CC_END + CONV_WIDTH
IN_WIDTH = CH_END

kernel_name = "hybrid_macaron_swa_shortconv"


def rms_norm(x, gain):
    xf = x.astype(jnp.float32)
    inv = lax.rsqrt(jnp.mean(xf * xf, axis=-1, keepdims=True) + NORM_EPS)
    return (xf * inv).astype(x.dtype) * gain


def swiglu(h, w_gate, w_up, w_down):
    return (jax.nn.silu(h @ w_gate) * (h @ w_up)) @ w_down


def alibi_slopes(n_heads):
    return jnp.exp2(-8.0 * jnp.arange(1, n_heads + 1, dtype=jnp.float32) / n_heads)


def short_conv(b_gate, c_gate, h_conv, conv_w):
    u = c_gate * h_conv
    w = conv_w.astype(u.dtype)[:, None, :]
    y = lax.conv_general_dilated(
        u, w, window_strides=(1,), padding=[(CONV_K - 1, 0)],
        dimension_numbers=("NWC", "WIO", "NWC"), feature_group_count=CONV_WIDTH)
    return b_gate * y


def sliding_window_attention(q, k, v, sink):
    bsz, seq = q.shape[0], q.shape[1]
    nb = seq // BLOCK
    qb = q.reshape(bsz, nb, BLOCK, N_KV_HEADS, GQA_GROUP, HEAD_DIM)
    kb = k.reshape(bsz, nb, BLOCK, N_KV_HEADS, HEAD_DIM)
    vb = v.reshape(bsz, nb, BLOCK, N_KV_HEADS, HEAD_DIM)
    pad = ((0, 0), (1, 0), (0, 0), (0, 0), (0, 0))
    k_band = jnp.concatenate([jnp.pad(kb, pad)[:, :-1], kb], axis=2)
    v_band = jnp.concatenate([jnp.pad(vb, pad)[:, :-1], vb], axis=2)

    scale = 1.0 / math.sqrt(HEAD_DIM)
    scores = jnp.einsum("bnqkgd,bnskd->bnkgqs", qb, k_band).astype(jnp.float32) * scale

    qi = jnp.arange(BLOCK)[:, None]
    kj = jnp.arange(2 * BLOCK)[None, :]
    dist = qi + BLOCK - kj
    in_window = (dist >= 0) & (dist < WINDOW)
    blk = jnp.arange(nb)[:, None, None]
    mask = in_window[None] & ((blk > 0) | (kj[None] >= BLOCK))

    slopes = alibi_slopes(N_Q_HEADS).reshape(N_KV_HEADS, GQA_GROUP)
    bias = -slopes[:, :, None, None] * dist.astype(jnp.float32)[None, None]
    scores = scores + bias[None, None]
    mask_b = mask[None, :, None, None]
    scores = jnp.where(mask_b, scores, -jnp.inf)

    sink_l = sink.astype(jnp.float32).reshape(1, 1, N_KV_HEADS, GQA_GROUP, 1, 1)
    m = jnp.maximum(jnp.max(scores, axis=-1, keepdims=True), sink_l)
    p = jnp.where(mask_b, jnp.exp(scores - m), 0.0)
    denom = jnp.sum(p, axis=-1, keepdims=True) + jnp.exp(sink_l - m)
    probs = (p / denom).astype(v.dtype)
    out = jnp.einsum("bnkgqs,bnskd->bnqkgd", probs, v_band)
    return out.reshape(bsz, seq, ATTN_WIDTH)


def setup_inputs(seed: int = 0) -> dict:
    key = jax.random.key(seed)
    ks = jax.random.split(key, 20)
    f32 = jnp.float32

    def w(k, shape, fan_in):
        return jax.random.normal(k, shape, f32) * (fan_in ** -0.5)

    def gain(k, shape):
        return 1.0 + 0.05 * jax.random.normal(k, shape, f32)

    return {
        "x": jax.random.normal(ks[0], (BATCH, SEQ, D_MODEL), f32),
        "ffn1_norm": gain(ks[1], (DEPTH, D_MODEL)),
        "ffn1_wg": w(ks[2], (DEPTH, D_MODEL, D_FF), D_MODEL),
        "ffn1_wu": w(ks[3], (DEPTH, D_MODEL, D_FF), D_MODEL),
        "ffn1_wd": w(ks[4], (DEPTH, D_FF, D_MODEL), D_FF),
        "mix_norm": gain(ks[5], (DEPTH, D_MODEL)),
        "w_in": w(ks[6], (DEPTH, D_MODEL, IN_WIDTH), D_MODEL),
        "conv_w": w(ks[7], (DEPTH, CONV_K, CONV_WIDTH), CONV_K),
        "attn_sink": 0.5 * jax.random.normal(ks[8], (DEPTH, N_Q_HEADS), f32),
        "w_out": w(ks[9], (DEPTH, MIX_WIDTH, D_MODEL), MIX_WIDTH),
        "ffn2_norm": gain(ks[10], (DEPTH, D_MODEL)),
        "ffn2_wg": w(ks[11], (DEPTH, D_MODEL, D_FF), D_MODEL),
        "ffn2_wu": w(ks[12], (DEPTH, D_MODEL, D_FF), D_MODEL),
        "ffn2_wd": w(ks[13], (DEPTH, D_FF, D_MODEL), D_FF),
        "final_norm": gain(ks[14], (D_MODEL,)),
    }


def reference(x, ffn1_norm, ffn1_wg, ffn1_wu, ffn1_wd, mix_norm, w_in, conv_w,
              attn_sink, w_out, ffn2_norm, ffn2_wg, ffn2_wu, ffn2_wd, final_norm):
    bsz, seq, _ = x.shape
    for l in range(DEPTH):
        x = x + 0.5 * swiglu(rms_norm(x, ffn1_norm[l]), ffn1_wg[l], ffn1_wu[l], ffn1_wd[l])

        h = rms_norm(x, mix_norm[l])
        z = h @ w_in[l]
        q = z[..., :Q_END].reshape(bsz, seq, N_Q_HEADS, HEAD_DIM)
        k = z[..., Q_END:K_END].reshape(bsz, seq, N_KV_HEADS, HEAD_DIM)
        v = z[..., K_END:V_END].reshape(bsz, seq, N_KV_HEADS, HEAD_DIM)
        attn_out = sliding_window_attention(q, k, v, attn_sink[l])
        conv_out = short_conv(z[..., V_END:CB_END], z[..., CB_END:CC_END],
                              z[..., CC_END:CH_END], conv_w[l])
        x = x + jnp.concatenate([attn_out, conv_out], axis=-1) @ w_out[l]

        x = x + 0.5 * swiglu(rms_norm(x, ffn2_norm[l]), ffn2_wg[l], ffn2_wu[l], ffn2_wd[l])
    return rms_norm(x, final_norm)
```

```cpp
#include <hip/hip_runtime.h>
#include <hip/hip_cooperative_groups.h>
#include <cstdio>
#include <cstdint>
#include <cmath>
namespace cg = cooperative_groups;
namespace pg8 {
#define PG8_LAS __attribute__((address_space(3)))
typedef unsigned short bf16_t;
typedef short bf16x8 __attribute__((ext_vector_type(8)));
typedef float f32x4 __attribute__((ext_vector_type(4)));
typedef unsigned u32x4 __attribute__((ext_vector_type(4)));
constexpr int BM = 256, BK = 64, HALF = 128, HTB = HALF * BK * 2  , STAGE_BYTES = 8 * HTB, NXCD = 8, WGM = 8;

__host__ __device__ __forceinline__ int lds_byte(int r, int c) { const int st = (r >> 4) * 2 + (c >> 5), rr = r & 15, cc = c & 31, ob = rr * 64 + cc * 2; return st * 1024 + (ob ^ (((ob >> 9) & 1) << 5)); }
__host__ __device__ __forceinline__ void stage_rc(int b, int& R, int& C) { const int st = b / 1024, sb = b % 1024, swz = sb ^ (((sb >> 9) & 1) << 5); R = (st >> 1) * 16 + swz / 64; C = (st & 1) * 32 + (swz % 64) / 2; }
__host__ __device__ __forceinline__ int perm32(int rho) { const int n = rho >> 4, i = rho & 15; return 8 * (i >> 2) + 4 * n + (i & 3); }

struct Unit { int pm, pn; };
struct Gemm { const bf16_t* A; const bf16_t* Bt; int M, N, K; };

struct StaticOrder {
    int nM, nN, nwg, G, c;
    __host__ __device__ void init(int M, int N, int G_, int c_) { nM = M / BM; nN = N / BM; nwg = nM * nN; G = G_; c = c_; }
    __host__ __device__ bool next(int i, Unit& u) const {
        const long L = (long)i * G + c; if (L >= nwg) return false;
        int wgid = (int)L; { const int q = nwg / NXCD, r = nwg % NXCD, xcd = wgid % NXCD, off = wgid / NXCD; wgid = (xcd < r ? xcd * (q + 1) : r * (q + 1) + (xcd - r) * q) + off; }
        const int nig = WGM * nN, gid = wgid / nig, fm = gid * WGM, gsz = (nM - fm) < WGM ? (nM - fm) : WGM;
        u.pm = fm + ((wgid % nig) % gsz); u.pn = (wgid % nig) / gsz; return true;
    }
    __device__ __forceinline__ void a_ready(const Unit&) const {}
    __device__ __forceinline__ void done(const Unit&) const {}
};

__device__ __forceinline__ unsigned cvt_pk_bf16(float lo, float hi) { unsigned r; asm volatile("v_cvt_pk_bf16_f32 %0, %1, %2" : "=v"(r) : "v"(lo), "v"(hi)); return r; }
typedef float f32x2z __attribute__((ext_vector_type(2)));
__device__ __forceinline__ f32x4 zero4() { f32x2z lo, hi; asm volatile("v_pk_mov_b32 %0, 0, 0" : "=v"(lo)); asm volatile("v_pk_mov_b32 %0, 0, 0" : "=v"(hi)); return (f32x4){lo[0], lo[1], hi[0], hi[1]}; }
typedef unsigned u32x2 __attribute__((ext_vector_type(2)));
constexpr float RMS_EPS = 1e-6f, INV_D = 1.0f / 1024.0f;
__device__ __forceinline__ float silu_mul(float g, float u) { return g * __builtin_amdgcn_rcpf(1.0f + __builtin_amdgcn_exp2f(g * -1.44269504089f)) * u; }
struct NoCvt { __device__ __forceinline__ void load(int) {} __device__ __forceinline__ void mid() {} __device__ __forceinline__ void finish() {} };
template <class Cvt> struct EpiSwiglu {
    static constexpr bool PERM = true, AFTER_DRAIN = false;
    static constexpr bool NEEDS_SCALE = true;
    bf16_t* O; int ldc; const float* rowss; Cvt cvt0;
    __device__ __forceinline__ void operator()(const f32x4 (&acc)[2][2][4][2], const Unit& u, int wr, int wc, int fr, int fq, const PG8_LAS float* stab, int ui) const {
        Cvt cvt = cvt0; cvt.load(ui);
        const int row0 = u.pm * BM + wr * 64 + fr, col0 = u.pn * HALF + wc * 32 + 8 * fq;
#pragma unroll
        for (int ai = 0; ai < 2; ++ai) {
#pragma unroll
            for (int m = 0; m < 4; ++m) { const int row = row0 + ai * HALF + m * 16; const float s = stab ? stab[wr * 64 + fr + ai * HALF + m * 16] : __builtin_amdgcn_rsqf(rowss[row] * INV_D + RMS_EPS);
                const float c = s * -1.44269504089f, is2 = __builtin_amdgcn_rcpf(s * s); f32x4 o[2];
#pragma unroll
                for (int n = 0; n < 2; ++n) { const f32x4 g = acc[ai][0][m][n], uu = acc[ai][1][m][n]; const f32x4 t = g * c; f32x4 e;
                    e[0] = __builtin_amdgcn_exp2f(t[0]); e[1] = __builtin_amdgcn_exp2f(t[1]); e[2] = __builtin_amdgcn_exp2f(t[2]); e[3] = __builtin_amdgcn_exp2f(t[3]);
                    const f32x4 d = e * is2 + is2; f32x4 r; r[0] = __builtin_amdgcn_rcpf(d[0]); r[1] = __builtin_amdgcn_rcpf(d[1]); r[2] = __builtin_amdgcn_rcpf(d[2]); r[3] = __builtin_amdgcn_rcpf(d[3]);
                    o[n] = (g * uu) * r; }
                u32x4 w; w.x = cvt_pk_bf16(o[0][0], o[0][1]); w.y = cvt_pk_bf16(o[0][2], o[0][3]); w.z = cvt_pk_bf16(o[1][0], o[1][1]); w.w = cvt_pk_bf16(o[1][2], o[1][3]);
                *(u32x4*)(O + (size_t)row * ldc + col0) = w; asm volatile("" ::: "memory"); }
            if (ai == 0) cvt.mid(); }
        cvt.finish();
    }
};
struct EpiRowScale {
    static constexpr bool PERM = true, AFTER_DRAIN = false;
    static constexpr bool NEEDS_SCALE = true;
    bf16_t* O; int ldc; const float* rowss;
    __device__ __forceinline__ void operator()(const f32x4 (&acc)[2][2][4][2], const Unit& u, int wr, int wc, int fr, int fq, const PG8_LAS float* stab, int ui) const {
        const int row0 = u.pm * BM + wr * 64 + fr, col0 = u.pn * BM + wc * 32 + 8 * fq;
#pragma unroll
        for (int ai = 0; ai < 2; ++ai)
#pragma unroll
            for (int m = 0; m < 4; ++m) { const int row = row0 + ai * HALF + m * 16; const float s = stab ? stab[wr * 64 + fr + ai * HALF + m * 16] : __builtin_amdgcn_rsqf(rowss[row] * INV_D + RMS_EPS);
#pragma unroll
                for (int bj = 0; bj < 2; ++bj) { const f32x4 v0 = acc[ai][bj][m][0] * s, v1 = acc[ai][bj][m][1] * s;
                    u32x4 w; w.x = cvt_pk_bf16(v0[0], v0[1]); w.y = cvt_pk_bf16(v0[2], v0[3]); w.z = cvt_pk_bf16(v1[0], v1[1]); w.w = cvt_pk_bf16(v1[2], v1[3]);
                    *(u32x4*)(O + (size_t)row * ldc + col0 + bj * HALF) = w; } asm volatile("" ::: "memory"); }
    }
};
struct EpiResid {
    static constexpr bool PERM = true, AFTER_DRAIN = false;
    static constexpr bool NEEDS_SCALE = false;
    bf16_t* xb; float* rowss_out; float alpha;
    __device__ __forceinline__ void operator()(const f32x4 (&acc)[2][2][4][2], const Unit& u, int wr, int wc, int fr, int fq, const PG8_LAS float*, int) const {
        const int row0 = u.pm * BM + wr * 64 + fr, col0 = u.pn * BM + wc * 32 + 8 * fq;
        bf16_t* p0 = xb + (size_t)row0 * 1024 + col0;
        u32x4 pre[2][4][2];
#pragma unroll
        for (int ai = 0; ai < 2; ++ai)
#pragma unroll
            for (int m = 0; m < 4; ++m)
#pragma unroll
                for (int bj = 0; bj < 2; ++bj) pre[ai][m][bj] = *(const u32x4*)(p0 + (size_t)(ai * HALF + m * 16) * 1024 + bj * HALF);
        asm volatile("" ::: "memory");
#pragma unroll
        for (int ai = 0; ai < 2; ++ai)
#pragma unroll
            for (int m = 0; m < 4; ++m) { f32x4 ssv = {0.f, 0.f, 0.f, 0.f};
#pragma unroll
                for (int bj = 0; bj < 2; ++bj) { const u32x4 b = pre[ai][m][bj];
                    f32x4 b0, b1; b0[0] = __uint_as_float(b.x << 16); b0[1] = __uint_as_float(b.x & 0xffff0000u); b0[2] = __uint_as_float(b.y << 16); b0[3] = __uint_as_float(b.y & 0xffff0000u);
                    b1[0] = __uint_as_float(b.z << 16); b1[1] = __uint_as_float(b.z & 0xffff0000u); b1[2] = __uint_as_float(b.w << 16); b1[3] = __uint_as_float(b.w & 0xffff0000u);
                    const f32x4 o0 = acc[ai][bj][m][0] * alpha + b0, o1 = acc[ai][bj][m][1] * alpha + b1;
                    ssv = o0 * o0 + ssv; ssv = o1 * o1 + ssv;
                    u32x4 w; w.x = cvt_pk_bf16(o0[0], o0[1]); w.y = cvt_pk_bf16(o0[2], o0[3]); w.z = cvt_pk_bf16(o1[0], o1[1]); w.w = cvt_pk_bf16(o1[2], o1[3]);
                    *(u32x4*)(p0 + (size_t)(ai * HALF + m * 16) * 1024 + bj * HALF) = w; }
                float ss = (ssv[0] + ssv[1]) + (ssv[2] + ssv[3]);
                ss += __shfl_xor(ss, 16); ss += __shfl_xor(ss, 32);
                if (fq == 0) unsafeAtomicAdd(rowss_out + row0 + ai * HALF + m * 16, ss); }
    }
};
template <class Epi, class Sched, bool ALIGN_EPI = false, bool SP2 = false>
__device__ __forceinline__ void gemm_phase(PG8_LAS unsigned char* lds, const Gemm g, const Sched& S, const Epi& E) {
    int tid_ = threadIdx.x; asm volatile("" : "+v"(tid_));
    const int tid = tid_, wid = __builtin_amdgcn_readfirstlane(tid >> 6), lane = tid & 63, wr = wid >> 2, wc = wid & 3, fr = lane & 15, fq = lane >> 4;
    const int K = g.K, nt = K / BK;
    PG8_LAS float* const stab = (PG8_LAS float*)(lds + STAGE_BYTES + 1024);
    unsigned voffA[2], voffB[2];
#pragma unroll
    for (int i = 0; i < 2; ++i) { int R, C; stage_rc(tid * 16 + i * 8192, R, C); const int Rb = Epi::PERM ? ((R & ~31) + perm32(R & 31)) : R;
        voffA[i] = (unsigned)(R * K + C) * 2u; voffB[i] = (unsigned)(Rb * K + C) * 2u; }
    const size_t kstep = (size_t)(BK * 2);
    const size_t hstep = (size_t)HALF * K * 2;
    const size_t tstep = 2 * hstep;
    const unsigned ldsw = (unsigned)wid * 1024u;
    const int aoff = lds_byte(wr * 64 + fr, fq * 8), boff = lds_byte(wc * 32 + fr, fq * 8);
#define PG8_SA(b, h) (((b) * 2 + (h)) * HTB)
#define PG8_SB(b, h) ((4 + (b) * 2 + (h)) * HTB)
#define PG8_STAGE(bufoff, gbase, voff) do { _Pragma("unroll") for (int _i = 0; _i < 2; ++_i) \
        __builtin_amdgcn_global_load_lds((const unsigned*)((const char*)(gbase) + (voff)[_i]), (PG8_LAS unsigned*)(lds + (bufoff) + ldsw + _i * 8192), 16, 0, 0); } while (0)
#define PG8_LDA(dst, b, h) do { _Pragma("unroll") for (int m = 0; m < 4; ++m) _Pragma("unroll") for (int k = 0; k < 2; ++k) dst[m][k] = *(const PG8_LAS bf16x8*)(lds + PG8_SA(b, h) + aoff + m * 2048 + k * 1024); } while (0)
#define PG8_LDB(dst, b, h) do { _Pragma("unroll") for (int n = 0; n < 2; ++n) _Pragma("unroll") for (int k = 0; k < 2; ++k) dst[n][k] = *(const PG8_LAS bf16x8*)(lds + PG8_SB(b, h) + boff + n * 2048 + k * 1024); } while (0)
#define PG8_MMA(ai, bj, At, Bt) do { __builtin_amdgcn_s_setprio(1); _Pragma("unroll") for (int m = 0; m < 4; ++m) _Pragma("unroll") for (int n = 0; n < 2; ++n) _Pragma("unroll") for (int k = 0; k < 2; ++k) \
        acc[ai][bj][m][n] = __builtin_amdgcn_mfma_f32_16x16x32_bf16(Bt[n][k], At[m][k], acc[ai][bj][m][n], 0, 0, 0); __builtin_amdgcn_s_setprio(0); } while (0)
#define PG8_WAIT_V(n) asm volatile("s_waitcnt vmcnt(" #n ")" ::: "memory")
#define PG8_WAIT_L(n) asm volatile("s_waitcnt lgkmcnt(" #n ")" ::: "memory")
#define PG8_BAR __builtin_amdgcn_s_barrier()
#define PG8_SCHED __builtin_amdgcn_sched_barrier(0)
    Unit cur, nxt; int ui = 0;
    if (!S.next(0, cur)) return;
    f32x4 acc[2][2][4][2];
#pragma unroll
    for (int a = 0; a < 2; ++a)
#pragma unroll
        for (int b = 0; b < 2; ++b)
#pragma unroll
            for (int m = 0; m < 4; ++m)
#pragma unroll
                for (int n = 0; n < 2; ++n) acc[a][b][m][n] = zero4();
    bf16x8 At[4][2], B0[2][2], B1[2][2];
    const char* cA = (const char*)g.A + (size_t)cur.pm * tstep; const char* cB = (const char*)g.Bt + (size_t)cur.pn * tstep;
    S.a_ready(cur);
    if constexpr (SP2) {
        PG8_STAGE(PG8_SB(0, 0), cB, voffB); PG8_STAGE(PG8_SB(0, 1), cB + hstep, voffB); PG8_STAGE(PG8_SA(0, 0), cA, voffA); PG8_STAGE(PG8_SA(0, 1), cA + hstep, voffA);
        if constexpr (Epi::NEEDS_SCALE) { Unit tu;
        for (int i = 0; i < 12 && S.next(i, tu); ++i) if (tid < 256) stab[i * 256 + tid] = __builtin_amdgcn_rsqf(E.rowss[tu.pm * BM + tid] * INV_D + RMS_EPS);
        asm volatile("s_waitcnt vmcnt(0) lgkmcnt(0)" ::: "memory"); }
        if (wr == 1) PG8_BAR;
        PG8_WAIT_V(2); PG8_BAR;
        PG8_STAGE(PG8_SB(1, 0), cB + kstep, voffB); PG8_STAGE(PG8_SA(1, 0), cA + kstep, voffA); PG8_STAGE(PG8_SB(1, 1), cB + hstep + kstep, voffB);
        PG8_WAIT_V(6); PG8_BAR;
    } else {
        PG8_STAGE(PG8_SB(0, 0), cB, voffB); PG8_STAGE(PG8_SA(0, 0), cA, voffA); PG8_STAGE(PG8_SB(0, 1), cB + hstep, voffB); PG8_STAGE(PG8_SA(0, 1), cA + hstep, voffA);
        if constexpr (Epi::NEEDS_SCALE) { Unit tu;
        for (int i = 0; i < 12 && S.next(i, tu); ++i) if (tid < 256) stab[i * 256 + tid] = __builtin_amdgcn_rsqf(E.rowss[tu.pm * BM + tid] * INV_D + RMS_EPS);
        asm volatile("s_waitcnt vmcnt(0) lgkmcnt(0)" ::: "memory"); }
        if (wr == 1) PG8_BAR;
        PG8_WAIT_V(4); PG8_BAR;
        PG8_STAGE(PG8_SB(1, 0), cB + kstep, voffB); PG8_STAGE(PG8_SA(1, 0), cA + kstep, voffA); PG8_STAGE(PG8_SB(1, 1), cB + hstep + kstep, voffB);
        PG8_WAIT_V(6); PG8_BAR;
    }
    for (;;) {
        const bool has_next = S.next(ui + 1, nxt);
        const char* nA = has_next ? (const char*)g.A + (size_t)nxt.pm * tstep : cA; const char* nB = has_next ? (const char*)g.Bt + (size_t)nxt.pn * tstep : cB;
        for (int t = 0; t < nt; t += 2) {
            const bool last = (t == nt - 2);
            const char* a1 = cA + (size_t)(t + 1) * kstep;
            const char* a2 = last ? nA : cA + (size_t)(t + 2) * kstep; const char* b2 = last ? nB : cB + (size_t)(t + 2) * kstep;
            const char* a3 = a2 + kstep; const char* b3 = b2 + kstep;
            if (last && has_next) S.a_ready(nxt);
            if constexpr (SP2) {
            PG8_LDB(B0, 0, 0); PG8_LDB(B1, 0, 1); PG8_SCHED; PG8_LDA(At, 0, 0); PG8_STAGE(PG8_SA(1, 1), a1 + hstep, voffA);
            PG8_WAIT_V(8); PG8_WAIT_L(0); PG8_BAR; PG8_MMA(0, 0, At, B0); PG8_MMA(0, 1, At, B1); PG8_BAR; PG8_SCHED;
            PG8_LDA(At, 0, 1); PG8_STAGE(PG8_SB(0, 0), b2, voffB); PG8_STAGE(PG8_SB(0, 1), b2 + hstep, voffB); PG8_STAGE(PG8_SA(0, 0), a2, voffA);
            PG8_WAIT_V(8); PG8_WAIT_L(0); PG8_BAR; PG8_MMA(1, 0, At, B0); PG8_MMA(1, 1, At, B1); PG8_BAR; PG8_SCHED;
            PG8_LDB(B0, 1, 0); PG8_LDB(B1, 1, 1); PG8_SCHED; PG8_LDA(At, 1, 0); PG8_STAGE(PG8_SA(0, 1), a2 + hstep, voffA);
            PG8_WAIT_V(8); PG8_WAIT_L(0); PG8_BAR; PG8_MMA(0, 0, At, B0); PG8_MMA(0, 1, At, B1); PG8_BAR; PG8_SCHED;
            PG8_LDA(At, 1, 1); PG8_STAGE(PG8_SB(1, 0), b3, voffB); PG8_STAGE(PG8_SB(1, 1), b3 + hstep, voffB); PG8_STAGE(PG8_SA(1, 0), a3, voffA);
            PG8_WAIT_V(8); PG8_WAIT_L(0); PG8_BAR; PG8_MMA(1, 0, At, B0); PG8_MMA(1, 1, At, B1); PG8_BAR; PG8_SCHED;
            } else {
            PG8_LDB(B0, 0, 0); PG8_SCHED; PG8_LDA(At, 0, 0); PG8_STAGE(PG8_SA(1, 1), a1 + hstep, voffA);
            PG8_WAIT_L(8); PG8_BAR; PG8_WAIT_L(0); PG8_MMA(0, 0, At, B0); PG8_BAR; PG8_SCHED;
            PG8_LDB(B1, 0, 1); PG8_STAGE(PG8_SB(0, 0), b2, voffB);
            PG8_BAR; PG8_WAIT_L(0); PG8_MMA(0, 1, At, B1); PG8_BAR;
            PG8_LDA(At, 0, 1); PG8_STAGE(PG8_SA(0, 0), a2, voffA);
            PG8_BAR; PG8_WAIT_L(0); PG8_MMA(1, 0, At, B0); PG8_BAR; PG8_SCHED;
            PG8_STAGE(PG8_SB(0, 1), b2 + hstep, voffB);
            PG8_WAIT_V(6); PG8_BAR; PG8_MMA(1, 1, At, B1); PG8_BAR;
            PG8_LDB(B0, 1, 0); PG8_SCHED; PG8_LDA(At, 1, 0); PG8_STAGE(PG8_SA(0, 1), a2 + hstep, voffA);
            PG8_WAIT_L(8); PG8_BAR; PG8_WAIT_L(0); PG8_MMA(0, 0, At, B0); PG8_BAR; PG8_SCHED;
            PG8_LDB(B1, 1, 1); PG8_STAGE(PG8_SB(1, 0), b3, voffB);
            PG8_BAR; PG8_WAIT_L(0); PG8_MMA(0, 1, At, B1); PG8_BAR;
            PG8_LDA(At, 1, 1); PG8_STAGE(PG8_SA(1, 0), a3, voffA);
            PG8_BAR; PG8_WAIT_L(0); PG8_MMA(1, 0, At, B0); PG8_BAR; PG8_SCHED;
            PG8_STAGE(PG8_SB(1, 1), b3 + hstep, voffB);
            PG8_WAIT_V(6); PG8_BAR; PG8_MMA(1, 1, At, B1); PG8_BAR;
            }
        }
        if constexpr (ALIGN_EPI) { if (wr == 0) PG8_BAR; }
        if constexpr (!Epi::AFTER_DRAIN) { E(acc, cur, wr, wc, fr, fq, ui < 12 ? stab + ui * 256 : (const PG8_LAS float*)nullptr, ui); S.done(cur); }
        if (!has_next) break;
#pragma unroll
        for (int a = 0; a < 2; ++a)
#pragma unroll
            for (int b = 0; b < 2; ++b)
#pragma unroll
                for (int m = 0; m < 4; ++m)
#pragma unroll
                    for (int n = 0; n < 2; ++n) acc[a][b][m][n] = zero4();
        cur = nxt; cA = nA; cB = nB; ++ui;
        if constexpr (ALIGN_EPI) { if (wr == 1) PG8_BAR; }
    }
    PG8_WAIT_V(0);
    if constexpr (!ALIGN_EPI) { if (wr == 0) PG8_BAR; }
    PG8_BAR;
    if constexpr (Epi::AFTER_DRAIN) { E.fused(acc, cur, wr, wc, fr, fq, lds, wid, lane); S.done(cur); }
#undef PG8_SA
#undef PG8_SB
#undef PG8_STAGE
#undef PG8_LDA
#undef PG8_LDB
#undef PG8_MMA
#undef PG8_WAIT_V
#undef PG8_WAIT_L
#undef PG8_BAR
#undef PG8_SCHED
}
}

constexpr int NB = 4, SEQ = 8192, DM = 1024, FF = 2816, T = NB * SEQ, INW = 2304, HD = 64;
constexpr size_t MiB = 1u << 20;
constexpr size_t SZ_GU = (size_t)2 * FF * DM * 2, SZ_D = (size_t)DM * FF * 2, SZ_IN = (size_t)INW * DM * 2, SZ_OUT = (size_t)DM * DM * 2;
constexpr size_t OFF_GU1 = 0, OFF_D1 = OFF_GU1 + SZ_GU, OFF_IN = OFF_D1 + SZ_D, OFF_OUT = OFF_IN + SZ_IN, OFF_GU2 = OFF_OUT + SZ_OUT, OFF_D2 = OFF_GU2 + SZ_GU, SZ_LAYER = OFF_D2 + SZ_D;
constexpr size_t WS_ROWSS = 0;
constexpr size_t WS_W = 1 * MiB;
constexpr size_t WS_XB = 81 * MiB;
constexpr size_t WS_ACT = 145 * MiB;
constexpr size_t WS_Z = WS_ACT;
constexpr int ZP = FF;
constexpr size_t WS_MIX = 321 * MiB;
constexpr size_t WS_BAR = 385 * MiB;
constexpr size_t WS_END = 386 * MiB;
static_assert(WS_W + 2 * SZ_LAYER <= WS_XB && WS_XB + (size_t)T * DM * 2 <= WS_ACT && WS_ACT + (size_t)T * FF * 2 <= WS_MIX && WS_MIX + (size_t)T * DM * 2 <= WS_BAR, "ws map");
constexpr int LDS_BYTES = 147456;

#define GAS __attribute__((address_space(1)))
#define LAS __attribute__((address_space(3)))
typedef unsigned short bf16;
typedef unsigned v4u __attribute__((ext_vector_type(4)));
typedef unsigned v2u __attribute__((ext_vector_type(2)));
typedef float f32x4 __attribute__((ext_vector_type(4)));
typedef float f32x8 __attribute__((ext_vector_type(8)));
typedef float f32x16 __attribute__((ext_vector_type(16)));
typedef short bf16x8 __attribute__((ext_vector_type(8)));
typedef short s16x4 __attribute__((ext_vector_type(4)));
#define LDS_WAIT() asm volatile("s_waitcnt lgkmcnt(0)" ::: "memory")
using pg8::cvt_pk_bf16;

__device__ __forceinline__ float wave_sum(float v) {
#pragma unroll
    for (int o = 1; o < 64; o <<= 1) v += __shfl_xor(v, o);
    return v;
}
struct Args { const float* in[15]; float* out; unsigned char* ws; };
constexpr int I_G = (DM / 64) * (FF / 64), I_D = (FF / 64) * (DM / 64), I_IN = (DM / 64) * (INW / 64), I_OUT = (DM / 64) * (DM / 64);
constexpr int I_LAYER = 4 * I_G + 2 * I_D + I_IN + I_OUT;
constexpr int I_FIRST = 2 * I_G;
constexpr int I_REST = I_LAYER - I_FIRST;
struct CvtItem {
    f32x4 v[2][8]; const float* gain; bf16* dst; int K, k8; bool on;
    template <bool ISSUE = true> __device__ __forceinline__ void load_item(const Args& a, int l, int r, int lane) {
        unsigned char* wl = a.ws + WS_W + (size_t)l * SZ_LAYER; const size_t lg = (size_t)l * DM * FF;
        const float* W; int N, mode; const float* g = nullptr; bf16* WT; K = DM;
        if (r < I_G) { W = a.in[2] + lg; N = FF; g = a.in[1] + l * DM; WT = (bf16*)(wl + OFF_GU1); mode = 1; }
        else if ((r -= I_G) < I_G) { W = a.in[3] + lg; N = FF; g = a.in[1] + l * DM; WT = (bf16*)(wl + OFF_GU1); mode = 2; }
        else if ((r -= I_G) < I_D) { W = a.in[4] + lg; N = DM; K = FF; WT = (bf16*)(wl + OFF_D1); mode = 0; }
        else if ((r -= I_D) < I_IN) { W = a.in[6] + (size_t)l * DM * INW; N = INW; g = a.in[5] + l * DM; WT = (bf16*)(wl + OFF_IN); mode = 0; }
        else if ((r -= I_IN) < I_OUT) { W = a.in[9] + (size_t)l * DM * DM; N = DM; WT = (bf16*)(wl + OFF_OUT); mode = 0; }
        else if ((r -= I_OUT) < I_G) { W = a.in[11] + lg; N = FF; g = a.in[10] + l * DM; WT = (bf16*)(wl + OFF_GU2); mode = 1; }
        else if ((r -= I_G) < I_G) { W = a.in[12] + lg; N = FF; g = a.in[10] + l * DM; WT = (bf16*)(wl + OFF_GU2); mode = 2; }
        else { r -= I_G; W = a.in[13] + lg; N = DM; K = FF; WT = (bf16*)(wl + OFF_D2); mode = 0; }
        const int nblk = N / 64, kb = r / nblk, nb = r % nblk, k0 = 64 * kb, n0 = 64 * nb, j = lane >> 3, q = lane & 7;
        const float* src = W + (size_t)(k0 + 8 * j) * N + n0 + 4 * q; src_ = src; N_ = N;
        if constexpr (ISSUE) {
#pragma unroll
        for (int hh = 0; hh < 2; ++hh)
#pragma unroll
            for (int i = 0; i < 8; ++i) v[hh][i] = __builtin_nontemporal_load((const f32x4*)(src + (size_t)i * N + 32 * hh)); }
        const int r0 = (mode == 0) ? n0 : (256 * (n0 / 128) + (n0 % 128) + (mode == 2 ? 128 : 0));
        dst = WT + (size_t)(r0 + 4 * q) * K + k0 + 8 * j; k8 = k0 + 8 * j; gain = g;
    }
    const float* src_; int N_;
    __device__ __forceinline__ void load_half(int hh) {
#pragma unroll
        for (int i = 0; i < 8; ++i) v[0][i] = __builtin_nontemporal_load((const f32x4*)(src_ + (size_t)i * N_ + 32 * hh));
    }
    __device__ __forceinline__ void finish_half(int hh) {
        if (gain) { const f32x4 g0 = *(const f32x4*)(gain + k8), g1 = *(const f32x4*)(gain + k8 + 4);
            v[0][0] *= g0[0]; v[0][1] *= g0[1]; v[0][2] *= g0[2]; v[0][3] *= g0[3]; v[0][4] *= g1[0]; v[0][5] *= g1[1]; v[0][6] *= g1[2]; v[0][7] *= g1[3]; }
#pragma unroll
        for (int nn = 0; nn < 4; ++nn) { v4u o; o.x = cvt_pk_bf16(v[0][0][nn], v[0][1][nn]); o.y = cvt_pk_bf16(v[0][2][nn], v[0][3][nn]); o.z = cvt_pk_bf16(v[0][4][nn], v[0][5][nn]); o.w = cvt_pk_bf16(v[0][6][nn], v[0][7][nn]);
            *(v4u*)(dst + (size_t)(32 * hh + nn) * K) = o; }
    }
    __device__ __forceinline__ void finish_item() {
        if (gain) { const f32x4 g0 = *(const f32x4*)(gain + k8), g1 = *(const f32x4*)(gain + k8 + 4);
#pragma unroll
            for (int hh = 0; hh < 2; ++hh) { v[hh][0] *= g0[0]; v[hh][1] *= g0[1]; v[hh][2] *= g0[2]; v[hh][3] *= g0[3]; v[hh][4] *= g1[0]; v[hh][5] *= g1[1]; v[hh][6] *= g1[2]; v[hh][7] *= g1[3]; } }
#pragma unroll
        for (int hh = 0; hh < 2; ++hh)
#pragma unroll
            for (int nn = 0; nn < 4; ++nn) { v4u o; o.x = cvt_pk_bf16(v[hh][0][nn], v[hh][1][nn]); o.y = cvt_pk_bf16(v[hh][2][nn], v[hh][3][nn]); o.z = cvt_pk_bf16(v[hh][4][nn], v[hh][5][nn]); o.w = cvt_pk_bf16(v[hh][6][nn], v[hh][7][nn]);
                *(v4u*)(dst + (size_t)(32 * hh + nn) * K) = o; }
    }
};
struct CvtRest {
    const Args* a; CvtItem it;
    __device__ __forceinline__ void load(int ui) {
        const int lane = threadIdx.x & 63, gw = blockIdx.x * 8 + __builtin_amdgcn_readfirstlane(threadIdx.x >> 6), NGW = gridDim.x * 8;
        const int j = ui * NGW + (NGW - 1 - gw); it.on = j < I_REST;
        if (it.on) { const int jj = j + I_FIRST; it.load_item<false>(*a, jj / I_LAYER, jj % I_LAYER, lane); it.load_half(0); }
    }
    __device__ __forceinline__ void mid() { if (it.on) { it.finish_half(0); it.load_half(1); } }
    __device__ __forceinline__ void finish() { if (it.on) it.finish_half(1); }
};

__device__ __forceinline__ void p0_prologue(const Args& a) {
    int tid_ = threadIdx.x; asm volatile("" : "+v"(tid_));
    const int tid = tid_, lane = tid & 63, wave = tid >> 6;
    const int gw = blockIdx.x * 8 + wave, NGW = gridDim.x * 8;
    for (int it = NGW - 1 - gw; it < I_FIRST; it += NGW) { CvtItem c; c.load_item(a, 0, it, lane); c.finish_item(); }
    float* rowss = (float*)(a.ws + WS_ROWSS); bf16* XB = (bf16*)(a.ws + WS_XB);
    for (int m = gw * 4; m < T; m += NGW * 4) { const f32x4* xr = (const f32x4*)(a.in[0] + (size_t)m * DM) + lane; f32x4 v[4][4];
#pragma unroll
        for (int rr = 0; rr < 4; ++rr)
#pragma unroll
            for (int j = 0; j < 4; ++j) v[rr][j] = __builtin_nontemporal_load(xr + rr * 256 + 64 * j);
#pragma unroll
        for (int rr = 0; rr < 4; ++rr) { float s = 0.f;
#pragma unroll
            for (int j = 0; j < 4; ++j) s += (v[rr][j].x * v[rr][j].x + v[rr][j].y * v[rr][j].y) + (v[rr][j].z * v[rr][j].z + v[rr][j].w * v[rr][j].w);
            s = wave_sum(s); if (lane == 0) rowss[m + rr] = s;
            v2u* o8 = (v2u*)(XB + (size_t)(m + rr) * DM) + lane;
#pragma unroll
            for (int j = 0; j < 4; ++j) { v2u w; w.x = cvt_pk_bf16(v[rr][j].x, v[rr][j].y); w.y = cvt_pk_bf16(v[rr][j].z, v[rr][j].w); o8[64 * j] = w; } } }
    for (int i = blockIdx.x * 512 + tid; i < 7 * T; i += gridDim.x * 512) rowss[T + i] = 0.f;
}

__device__ __forceinline__ void cvt_layer1(const Args& a) {
    int tid_ = threadIdx.x; asm volatile("" : "+v"(tid_));
    const int lane = tid_ & 63, wave = tid_ >> 6; int w, nw;
    if (gridDim.x == 256) { if (blockIdx.x < 128) return; w = (blockIdx.x - 128) * 8 + wave; nw = 1024; } else { w = blockIdx.x * 8 + wave; nw = gridDim.x * 8; }
    for (int it = w; it < I_LAYER; it += nw) { CvtItem c; c.load_item(a, 1, it, lane); c.finish_item(); }
}

__device__ __forceinline__ void final_norm(const Args& a) {
    int tid_ = threadIdx.x; asm volatile("" : "+v"(tid_));
    const int tid = tid_, lane = tid & 63, wave = tid >> 6; const int gw = blockIdx.x * 8 + wave, NGW = gridDim.x * 8;
    const float* rowss = (const float*)(a.ws + WS_ROWSS) + 6 * T; const bf16* XB = (const bf16*)(a.ws + WS_XB);
    f32x4 g[4];
#pragma unroll
    for (int j = 0; j < 4; ++j) g[j] = ((const f32x4*)a.in[14])[lane + 64 * j];
    const bool quad = (gridDim.x == 256); const int qx = blockIdx.x & 7, qp = (blockIdx.x >> 3) & 7, qk = blockIdx.x >> 6;
    const int m_lo = quad ? 256 * (16 * qx + qp + 8 * (qk >> 1)) + 128 * (qk & 1) + 16 * wave : gw * 4, m_hi = quad ? m_lo + 16 : T, m_st = quad ? 4 : NGW * 4;
    for (int m = m_lo; m < m_hi; m += m_st) { v2u v[4][4]; float s[4];
#pragma unroll
        for (int rr = 0; rr < 4; ++rr) { s[rr] = __builtin_amdgcn_rsqf(rowss[m + rr] * pg8::INV_D + pg8::RMS_EPS);
#pragma unroll
            for (int j = 0; j < 4; ++j) v[rr][j] = ((const v2u*)(XB + (size_t)(m + rr) * DM))[lane + 64 * j]; }
#pragma unroll
        for (int rr = 0; rr < 4; ++rr) { f32x4* o = (f32x4*)(a.out + (size_t)(m + rr) * DM) + lane;
#pragma unroll
            for (int j = 0; j < 4; ++j) { f32x4 x; x[0] = __uint_as_float(v[rr][j].x << 16); x[1] = __uint_as_float(v[rr][j].x & 0xffff0000u); x[2] = __uint_as_float(v[rr][j].y << 16); x[3] = __uint_as_float(v[rr][j].y & 0xffff0000u);
                __builtin_nontemporal_store(x * s[rr] * g[j], o + 64 * j); } } }
}

constexpr int KP = 72, VP = 260;
constexpr int ATT_K_OFF = 0, ATT_V_OFF = 256 * KP * 2;
__device__ __forceinline__ int crow(int r, int hi) { return (r & 3) + 8 * (r >> 2) + 4 * hi; }
__device__ __forceinline__ f32x8 bf8_to_f32(v4u v) { f32x8 o; o[0] = __uint_as_float(v.x << 16); o[1] = __uint_as_float(v.x & 0xffff0000u); o[2] = __uint_as_float(v.y << 16); o[3] = __uint_as_float(v.y & 0xffff0000u);
    o[4] = __uint_as_float(v.z << 16); o[5] = __uint_as_float(v.z & 0xffff0000u); o[6] = __uint_as_float(v.w << 16); o[7] = __uint_as_float(v.w & 0xffff0000u); return o; }

__device__ __forceinline__ void attn_conv_phase(LAS unsigned char* lds, const bf16* Z, bf16* MIX, const float* sink, const float* convw, bool quad) {
    int tid_ = threadIdx.x; asm volatile("" : "+v"(tid_));
    const int tid = tid_, lane = tid & 63, wid = tid >> 6, lq = lane & 31, hi = lane >> 5;
    constexpr float LOG2E = 1.44269504089f;
    const int u_first = quad ? 4 * (16 * (blockIdx.x & 7) + ((blockIdx.x >> 3) & 7) + 8 * (blockIdx.x >> 7)) + 2 * ((blockIdx.x >> 6) & 1) : blockIdx.x, u_step = quad ? 1 : gridDim.x, u_end = quad ? u_first + 2 : 512;
    for (int u = u_first; u < u_end; u += u_step) {
        const int kvh = u & 1, n = (u >> 1) & 63, b = u >> 7;
        const size_t rowb = (size_t)b * SEQ;
        v4u kreg[4], v0reg[2], v1reg[2];
#pragma unroll
        for (int jj = 0; jj < 4; ++jj) { const int c = tid + 512 * jj, key = c >> 3, part = c & 7;
            int t = n * 128 - 128 + key; if (t < 0) t = key;
            kreg[jj] = *(const v4u*)(Z + (rowb + t) * ZP + 512 + kvh * 64 + part * 8); }
#pragma unroll
        for (int jj = 0; jj < 2; ++jj) { const int c = tid + 512 * jj, kp = c >> 3, part = c & 7;
            int t = n * 128 - 128 + 2 * kp; if (t < 0) t = 2 * kp;
            const bf16* src = Z + (rowb + t) * ZP + 640 + kvh * 64 + part * 8;
            v0reg[jj] = *(const v4u*)src; v1reg[jj] = *(const v4u*)(src + ZP); }
        { const int c0 = (tid & 63) * 8, r0 = u * 64 + (tid >> 6) * 8, t0 = r0 & (SEQ - 1);
          const f32x8 w0 = *(const f32x8*)(convw + c0), w1 = *(const f32x8*)(convw + 512 + c0), w2 = *(const f32x8*)(convw + 1024 + c0);
          const int rlo = (t0 > 0) ? r0 - 2 : r0;
          v4u hc[2], hh[2];
#pragma unroll
          for (int i = 0; i < 2; ++i) { const bf16* zr = Z + (size_t)(rlo + i) * ZP; hc[i] = *(const v4u*)(zr + 1280 + c0); hh[i] = *(const v4u*)(zr + 1792 + c0); }
          f32x8 u2, u1;
#pragma unroll
          for (int hb = 0; hb < 2; ++hb) {
              v4u zc[4], zh[4], zb[4];
#pragma unroll
              for (int i = 0; i < 4; ++i) { const bf16* zr = Z + (size_t)(r0 + 4 * hb + i) * ZP; zb[i] = *(const v4u*)(zr + 768 + c0); zc[i] = *(const v4u*)(zr + 1280 + c0); zh[i] = *(const v4u*)(zr + 1792 + c0); }
              if (hb == 0) { u2 = bf8_to_f32(hc[0]) * bf8_to_f32(hh[0]); u1 = bf8_to_f32(hc[1]) * bf8_to_f32(hh[1]);
                  if (t0 == 0) {
#pragma unroll
                      for (int i = 0; i < 8; ++i) { u1[i] = 0.f; u2[i] = 0.f; } } }
#pragma unroll
              for (int i = 0; i < 4; ++i) { const f32x8 u0 = bf8_to_f32(zc[i]) * bf8_to_f32(zh[i]);
                  const f32x8 y = bf8_to_f32(zb[i]) * (w0 * u2 + w1 * u1 + w2 * u0);
                  v4u o; o.x = cvt_pk_bf16(y[0], y[1]); o.y = cvt_pk_bf16(y[2], y[3]); o.z = cvt_pk_bf16(y[4], y[5]); o.w = cvt_pk_bf16(y[6], y[7]);
                  *(v4u*)(MIX + (size_t)(r0 + 4 * hb + i) * DM + 512 + c0) = o; u2 = u1; u1 = u0; }
              asm volatile("" ::: "memory"); } }
#pragma unroll
        for (int jj = 0; jj < 4; ++jj) { const int c = tid + 512 * jj, key = c >> 3, part = c & 7;
            *(LAS v4u*)(lds + ATT_K_OFF + key * (KP * 2) + part * 16) = kreg[jj]; }
#pragma unroll
        for (int jj = 0; jj < 2; ++jj) { const int c = tid + 512 * jj, kp = c >> 3, part = c & 7; const v4u v0 = v0reg[jj], v1 = v1reg[jj];
            LAS unsigned* d = (LAS unsigned*)(lds + ATT_V_OFF) + (8 * part) * (VP / 2) + kp;
            d[0 * (VP / 2)] = (v0.x & 0xffffu) | (v1.x << 16); d[1 * (VP / 2)] = (v0.x >> 16) | (v1.x & 0xffff0000u);
            d[2 * (VP / 2)] = (v0.y & 0xffffu) | (v1.y << 16); d[3 * (VP / 2)] = (v0.y >> 16) | (v1.y & 0xffff0000u);
            d[4 * (VP / 2)] = (v0.z & 0xffffu) | (v1.z << 16); d[5 * (VP / 2)] = (v0.z >> 16) | (v1.z & 0xffff0000u);
            d[6 * (VP / 2)] = (v0.w & 0xffffu) | (v1.w << 16); d[7 * (VP / 2)] = (v0.w >> 16) | (v1.w & 0xffff0000u); }
        __syncthreads();
        for (int it = wid; it < 16; it += 8) {
            const int g = it >> 2, qc = it & 3, h = kvh * 4 + g, q0 = qc * 32;
            const size_t qrow = rowb + (size_t)n * 128 + q0 + lq;
            bf16x8 qf[4];
#pragma unroll
            for (int kc = 0; kc < 4; ++kc) qf[kc] = *(const bf16x8*)(Z + qrow * ZP + h * 64 + kc * 16 + 8 * hi);
            f32x16 st[5];
#pragma unroll
            for (int kt = 0; kt < 5; ++kt) {
#pragma unroll
                for (int r = 0; r < 16; ++r) st[kt][r] = 0.f;
#pragma unroll
                for (int kc = 0; kc < 4; ++kc) { const bf16x8 kf = *(const LAS bf16x8*)(lds + ATT_K_OFF + (q0 + 32 * kt + lq) * (KP * 2) + (kc * 16 + 8 * hi) * 2);
                    st[kt] = __builtin_amdgcn_mfma_f32_32x32x16_bf16(kf, qf[kc], st[kt], 0, 0, 0); } asm volatile("" ::: "memory"); }
            const float slope = __builtin_amdgcn_exp2f(-(float)(h + 1));
            const float c1 = 0.125f * LOG2E, c2 = slope * LOG2E, sk = sink[h] * LOG2E;
            const int a = lq - 4 * hi;
            const float lb = -c2 * (float)(a + 128);
            f32x16 b0;
#pragma unroll
            for (int r = 0; r < 16; ++r) b0[r] = c2 * (float)((r & 3) + 8 * (r >> 2)) + lb;
            float mx = sk;
#pragma unroll
            for (int kt = 0; kt < 5; ++kt) { st[kt] = st[kt] * c1 + b0;
                if (kt == 0) {
#pragma unroll
                    for (int r = 0; r < 16; ++r) st[kt][r] = ((r & 3) + 8 * (r >> 2) > a) ? st[kt][r] : -INFINITY; }
                if (kt == 4) {
#pragma unroll
                    for (int r = 0; r < 16; ++r) st[kt][r] = ((r & 3) + 8 * (r >> 2) <= a) ? st[kt][r] : -INFINITY; }
                if (n == 0) {
#pragma unroll
                    for (int r = 0; r < 16; ++r) st[kt][r] = (q0 + 32 * kt + crow(r, hi) >= 128) ? st[kt][r] : -INFINITY; }
                float m = st[kt][0];
#pragma unroll
                for (int r = 1; r < 16; ++r) m = fmaxf(m, st[kt][r]);
                mx = fmaxf(mx, m + c2 * (float)(32 * kt)); }
            mx = fmaxf(mx, __shfl_xor(mx, 32));
            float sum = 0.f;
#pragma unroll
            for (int kt = 0; kt < 5; ++kt) { const float sh = mx - c2 * (float)(32 * kt); st[kt] = st[kt] - sh;
#pragma unroll
                for (int r = 0; r < 16; ++r) { const float p = __builtin_amdgcn_exp2f(st[kt][r]); st[kt][r] = p; sum += p; } }
            sum += __shfl_xor(sum, 32); sum += __builtin_amdgcn_exp2f(sk - mx);
            const float inv = 1.0f / sum;
            f32x16 ot[2];
#pragma unroll
            for (int r = 0; r < 16; ++r) { ot[0][r] = 0.f; ot[1][r] = 0.f; }
#pragma unroll
            for (int kt = 0; kt < 5; ++kt)
#pragma unroll
                for (int c = 0; c < 2; ++c) {
                    v4u pw; pw.x = cvt_pk_bf16(st[kt][8 * c + 0], st[kt][8 * c + 1]); pw.y = cvt_pk_bf16(st[kt][8 * c + 2], st[kt][8 * c + 3]);
                    pw.z = cvt_pk_bf16(st[kt][8 * c + 4], st[kt][8 * c + 5]); pw.w = cvt_pk_bf16(st[kt][8 * c + 6], st[kt][8 * c + 7]);
                    const bf16x8 pf = __builtin_bit_cast(bf16x8, pw);
#pragma unroll
                    for (int dt = 0; dt < 2; ++dt) { const LAS unsigned char* vp = lds + ATT_V_OFF + ((dt * 32 + lq) * VP + (q0 + 32 * kt + 16 * c + 4 * hi)) * 2;
                        const v2u lo = *(const LAS v2u*)vp, hi2 = *(const LAS v2u*)(vp + 16);
                        v4u vv; vv.x = lo.x; vv.y = lo.y; vv.z = hi2.x; vv.w = hi2.y;
                        ot[dt] = __builtin_amdgcn_mfma_f32_32x32x16_bf16(__builtin_bit_cast(bf16x8, vv), pf, ot[dt], 0, 0, 0); } asm volatile("" ::: "memory"); }
            bf16* orow = MIX + qrow * DM + h * 64;
#pragma unroll
            for (int dt = 0; dt < 2; ++dt)
#pragma unroll
                for (int r4 = 0; r4 < 4; ++r4) { v2u w; w.x = cvt_pk_bf16(ot[dt][4 * r4 + 0] * inv, ot[dt][4 * r4 + 1] * inv); w.y = cvt_pk_bf16(ot[dt][4 * r4 + 2] * inv, ot[dt][4 * r4 + 3] * inv);
                    *(v2u*)(orow + dt * 32 + 8 * r4 + 4 * hi) = w; }
        }
        __syncthreads();
    }
}

#define RLX_AGENT __ATOMIC_RELAXED, __HIP_MEMORY_SCOPE_AGENT
#define XB_TMO      128
#define XB_XCNT(j)  (256  + 64 * (j))
#define XB_XSUB(j)  (1280 + 64 * (j))
#define XB_XGEN(j)  (2304 + 64 * (j))
#define XB_TOP      3328
#define XB_TOPGEN   3392
#define XCD_BAR_WORDS 3456
#define XB_SPIN_CAP (1u << 18)

__device__ __forceinline__ unsigned xb_ld(unsigned* p)              { return __hip_atomic_load(p, __ATOMIC_RELAXED, __HIP_MEMORY_SCOPE_AGENT); }
__device__ __forceinline__ unsigned xb_add(unsigned* p, unsigned v) { return __hip_atomic_fetch_add(p, v, __ATOMIC_RELAXED, __HIP_MEMORY_SCOPE_AGENT); }
__device__ __forceinline__ unsigned xb_xcc_id() { return (unsigned)__builtin_amdgcn_s_getreg((3 << 11) | 20) & 0xFu; }
#define XB_SPIN(cond, bar) do { unsigned _sp = 0; while (cond) { __builtin_amdgcn_s_sleep(1); \
    if ((++_sp & 255u) == 0u) { if (xb_ld(&(bar)[XB_TMO])) break; if (_sp > XB_SPIN_CAP) { atomicAdd(&(bar)[XB_TMO], 1u); break; } } } } while (0)

struct XcdBarrier {
    unsigned* bar; unsigned x;
    unsigned total;
    volatile LAS unsigned* st;
};

__device__ __forceinline__ XcdBarrier xcd_barrier_post(unsigned* bar, volatile LAS unsigned* st, unsigned total) {
    XcdBarrier b; b.bar = bar; b.x = xb_xcc_id(); b.st = st; b.total = total;
    if (threadIdx.x == 0) (void)xb_add(&bar[XB_XCNT(b.x)], 1u);
    return b;
}
__device__ __forceinline__ void xcd_barrier_complete(unsigned* bar, unsigned x, unsigned G, unsigned& nloc, unsigned& nx) {
    unsigned sum, cnt, mine, sp = 0u;
    for (;;) {
        sum = 0u; cnt = 0u; mine = 0u;
#pragma unroll
        for (unsigned j = 0; j < 16; ++j) { const unsigned c = xb_ld(&bar[XB_XCNT(j)]); sum += c; cnt += (c > 0u) ? 1u : 0u; mine = (j == x) ? c : mine; }
        if (sum == G) break;
        __builtin_amdgcn_s_sleep(1);
        if ((++sp & 255u) == 0u) { if (xb_ld(&bar[XB_TMO])) break; if (sp > XB_SPIN_CAP) { atomicAdd(&bar[XB_TMO], 1u); break; } }
    }
    nloc = mine > 0u ? mine : 1u; nx = cnt > 0u ? cnt : 1u;
}

__device__ __forceinline__ void xcd_barrier(const XcdBarrier& b) {
    asm volatile("s_waitcnt vmcnt(0)" ::: "memory");
    __syncthreads();
    if (threadIdx.x == 0) {
        unsigned* bar = b.bar;
        __builtin_amdgcn_s_waitcnt(0);
        unsigned nloc = b.st[0], nx = b.st[1];
        if (nloc == 0u) { xcd_barrier_complete(bar, b.x, b.total, nloc, nx); b.st[0] = nloc; b.st[1] = nx; }
        const unsigned old = xb_add(&bar[XB_XSUB(b.x)], 1u);
        const unsigned gen = old / nloc;
        if (old + 1u == (gen + 1u) * nloc) {
            __builtin_amdgcn_fence(__ATOMIC_RELEASE, "agent");
            asm volatile("s_waitcnt vmcnt(0)" ::: "memory");
            const unsigned og = xb_add(&bar[XB_TOP], 1u);
            const unsigned tg = og / nx;
            if (og + 1u == (tg + 1u) * nx) xb_add(&bar[XB_TOPGEN], 1u);
            else XB_SPIN(xb_ld(&bar[XB_TOPGEN]) == tg, bar);
            __builtin_amdgcn_fence(__ATOMIC_ACQUIRE, "agent");
            xb_add(&bar[XB_XGEN(b.x)], 1u);
            asm volatile("s_waitcnt vmcnt(0)" ::: "memory");
        } else {
            XB_SPIN(xb_ld(&bar[XB_XGEN(b.x)]) == gen, bar);
            __builtin_amdgcn_fence(__ATOMIC_ACQUIRE, "agent");
            asm volatile("s_waitcnt vmcnt(0)" ::: "memory");
        }
    }
    __syncthreads();
}

__device__ __forceinline__ void quad_barrier(unsigned* qbase, int q, int mode, unsigned ntarget) {
    asm volatile("s_waitcnt vmcnt(0)" ::: "memory");
    __syncthreads();
    if (threadIdx.x == 0) {
        unsigned* qw = qbase + 64 * q;
        const unsigned mask = xb_ld(qw + 1);
        bool rel = (mask & (mask - 1u)) != 0u || (mode & 4);
        if (mode & 1) { const int x = q & 7, p = q >> 3;
            rel = rel || xb_ld(qbase + 64 * (p < 7 ? q + 8 : q - 56) + 1) != mask; if (p == 7 && x < 7) rel = rel || xb_ld(qbase + 64 * (q - 55) + 1) != mask; }
        if (rel) { __builtin_amdgcn_fence(__ATOMIC_RELEASE, "agent"); asm volatile("s_waitcnt vmcnt(0)" ::: "memory"); }
        if (mode & 4) xb_add(qbase + 64 * 64, 1u);
        const unsigned old = xb_add(qw, 1u), target = (old / 4u + 1u) * 4u; unsigned sp = 0u;
        while (xb_ld(qw) < target) { __builtin_amdgcn_s_sleep(1); if (++sp > XB_SPIN_CAP) break; }
        if (mode & 8) { sp = 0u; while (xb_ld(qbase + 64 * 64) < gridDim.x) { __builtin_amdgcn_s_sleep(1); if (++sp > XB_SPIN_CAP) break; } }
        if (mode & 3) { const int x = q & 7, p = q >> 3; int n0, n1 = -1;
            if (mode & 1) { if (p > 0) n0 = q - 8; else { n0 = q + 56; if (x > 0) n1 = q + 55; } }
            else           { if (p < 7) n0 = q + 8; else { n0 = q - 56; if (x < 7) n1 = q - 55; } }
            sp = 0u; while (xb_ld(qbase + 64 * n0) < ntarget) { __builtin_amdgcn_s_sleep(1); if (++sp > XB_SPIN_CAP) break; }
            if (n1 >= 0) { sp = 0u; while (xb_ld(qbase + 64 * n1) < ntarget) { __builtin_amdgcn_s_sleep(1); if (++sp > XB_SPIN_CAP) break; } } }
        __builtin_amdgcn_fence(__ATOMIC_ACQUIRE, "agent"); asm volatile("s_waitcnt vmcnt(0)" ::: "memory");
    }
    __syncthreads();
}
#define MKBAR(b) XcdBarrier b; { unsigned char* w_ = a.ws; asm volatile("" : "+s"(w_)); b.bar = (unsigned*)(w_ + WS_BAR); b.x = xb_xcc_id(); b.st = (volatile LAS unsigned*)(lds + 131072); b.total = gridDim.x; }
#define GSYNC() do { MKBAR(b_); xcd_barrier(b_); } while (0)
#define QSYNC(mode, ntarget) do { if (gridDim.x == 256) { unsigned char* w_ = a.ws; asm volatile("" : "+s"(w_)); quad_barrier((unsigned*)(w_ + WS_BAR) + XCD_BAR_WORDS, (int)(blockIdx.x & 63u), (mode), (ntarget)); } \
    else { MKBAR(b_); xcd_barrier(b_); } } while (0)
#define LSYNC() QSYNC(0, 0u)
__global__ void __launch_bounds__(512, 2) mk_fwd(Args a) {
    extern __shared__ __attribute__((aligned(16))) unsigned char lds_raw[];
    LAS unsigned char* lds = (LAS unsigned char*)lds_raw;
    cg::grid_group grid = cg::this_grid();
    float* rowss = (float*)(a.ws + WS_ROWSS);
    bf16* XB = (bf16*)(a.ws + WS_XB); bf16* ACT = (bf16*)(a.ws + WS_ACT); bf16* Zb = (bf16*)(a.ws + WS_Z); bf16* MIX = (bf16*)(a.ws + WS_MIX);
    const int G = gridDim.x, cb = blockIdx.x;

    if (threadIdx.x < 4) ((LAS unsigned*)(lds + 131072))[threadIdx.x] = 0u;
    __syncthreads();
    (void)xcd_barrier_post((unsigned*)(a.ws + WS_BAR), (volatile LAS unsigned*)(lds + 131072), gridDim.x);
    if (threadIdx.x == 0) __hip_atomic_fetch_or((unsigned*)(a.ws + WS_BAR) + XCD_BAR_WORDS + 64 * (blockIdx.x & 63u) + 1, 1u << xb_xcc_id(), __ATOMIC_RELAXED, __HIP_MEMORY_SCOPE_AGENT);
    if (a.ws == nullptr) grid.sync();
    p0_prologue(a);
    GSYNC();
#pragma unroll 1
    for (int l = 0; l < 2; ++l) {
        unsigned char* wl = a.ws + WS_W + (size_t)l * SZ_LAYER;
        const int qs0 = (l == 0) ? 0 : 7;
        {
            pg8::Gemm g{XB, (const bf16*)(wl + OFF_GU1), T, 2 * FF, DM}; pg8::StaticOrder S; S.init(T, 2 * FF, G, cb);
            if (l == 0) { CvtRest cv; cv.a = &a; cv.it.on = false; pg8::EpiSwiglu<CvtRest> E{ACT, FF, rowss + (3 * l + 0) * T, cv};
                pg8::gemm_phase<pg8::EpiSwiglu<CvtRest>, pg8::StaticOrder, true, true>(lds, g, S, E); }
            else { pg8::EpiSwiglu<pg8::NoCvt> E{ACT, FF, rowss + (3 * l + 0) * T, pg8::NoCvt{}};
                pg8::gemm_phase<pg8::EpiSwiglu<pg8::NoCvt>, pg8::StaticOrder, true, true>(lds, g, S, E); } }
        if (l == 0) GSYNC(); else LSYNC();
        {
            pg8::Gemm g{ACT, (const bf16*)(wl + OFF_D1), T, DM, FF}; pg8::StaticOrder S; S.init(T, DM, G, cb);
            pg8::EpiResid E{XB, rowss + (3 * l + 1) * T, 0.5f};
            pg8::gemm_phase<pg8::EpiResid, pg8::StaticOrder, true, true>(lds, g, S, E); }
        LSYNC();
        {
            pg8::Gemm g{XB, (const bf16*)(wl + OFF_IN), T, INW, DM}; pg8::StaticOrder S; S.init(T, INW, G, cb);
            pg8::EpiRowScale E{Zb, ZP, rowss + (3 * l + 1) * T};
            pg8::gemm_phase<pg8::EpiRowScale, pg8::StaticOrder, true, true>(lds, g, S, E); }
        if (l == 0) cvt_layer1(a);
        QSYNC(l == 0 ? 5 : 1, 4u * (unsigned)(qs0 + 2));
        attn_conv_phase(lds, Zb, MIX, a.in[8] + l * 8, a.in[7] + l * 3 * 512, gridDim.x == 256);
        LSYNC();
        {
            pg8::Gemm g{MIX, (const bf16*)(wl + OFF_OUT), T, DM, DM}; pg8::StaticOrder S; S.init(T, DM, G, cb);
            pg8::EpiResid E{XB, rowss + (3 * l + 2) * T, 1.0f};
            pg8::gemm_phase<pg8::EpiResid, pg8::StaticOrder, true, true>(lds, g, S, E); }
        QSYNC(2, 4u * (unsigned)(qs0 + 3));
        {
            pg8::Gemm g{XB, (const bf16*)(wl + OFF_GU2), T, 2 * FF, DM}; pg8::StaticOrder S; S.init(T, 2 * FF, G, cb);
            pg8::EpiSwiglu<pg8::NoCvt> E{ACT, FF, rowss + (3 * l + 2) * T, pg8::NoCvt{}};
            pg8::gemm_phase<pg8::EpiSwiglu<pg8::NoCvt>, pg8::StaticOrder, true, true>(lds, g, S, E); }
        LSYNC();
        {
            pg8::Gemm g{ACT, (const bf16*)(wl + OFF_D2), T, DM, FF}; pg8::StaticOrder S; S.init(T, DM, G, cb);
            pg8::EpiResid E{XB, rowss + (3 * l + 3) * T, 0.5f};
            pg8::gemm_phase<pg8::EpiResid, pg8::StaticOrder, true, true>(lds, g, S, E); }
        QSYNC(l == 0 ? 8 : 0, 0u);
    }
    final_norm(a);
}

extern "C" void kernel_launch(void* const* d_in, const int* in_sizes, int n_in, void* d_out, int out_size, void* d_ws, size_t ws_size, hipStream_t stream) {
    static int grid_blocks = 0;
    if (!grid_blocks) {
        if (n_in != 15 || out_size != T * DM || ws_size < WS_END) { fprintf(stderr, "kernel_launch: unexpected shapes (n_in %d out %d ws %zu)\n", n_in, out_size, ws_size); grid_blocks = -1; return; }
        int dev = 0, cus = 0, per_cu = 0;
        (void)hipGetDevice(&dev);
        (void)hipDeviceGetAttribute(&cus, hipDeviceAttributeMultiprocessorCount, dev);
        (void)hipFuncSetAttribute((const void*)mk_fwd, hipFuncAttributeMaxDynamicSharedMemorySize, LDS_BYTES);
        (void)hipOccupancyMaxActiveBlocksPerMultiprocessor(&per_cu, (const void*)mk_fwd, 512, LDS_BYTES);
        if (per_cu < 1) per_cu = 1;
        grid_blocks = cus * per_cu;
    }
    if (grid_blocks < 0) return;
    if (hipMemsetAsync((unsigned char*)d_ws + WS_BAR, 0, (XCD_BAR_WORDS + 64 * 64 + 64) * 4, stream) != hipSuccess) { fprintf(stderr, "kernel_launch: memset of the barrier words failed\n"); return; }
    Args a{};
    for (int i = 0; i < 15; ++i) a.in[i] = (const float*)d_in[i];
    a.out = (float*)d_out; a.ws = (unsigned char*)d_ws;
    void* args[] = {&a};
    hipError_t e = hipLaunchCooperativeKernel((void*)mk_fwd, dim3(grid_blocks), dim3(512), args, LDS_BYTES, stream);
    if (e != hipSuccess) fprintf(stderr, "cooperative launch failed: %s (grid %d)\n", hipGetErrorString(e), grid_blocks);
}
```

```cpp
#include <hip/hip_runtime.h>
#include <hip/hip_cooperative_groups.h>
#include <cstdio>
#include <cstdint>
#include <cmath>
namespace cg = cooperative_groups;
namespace pg8 {
#define PG8_LAS __attribute__((address_space(3)))
typedef unsigned short bf16_t;
typedef short bf16x8 __attribute__((ext_vector_type(8)));
typedef float f32x4 __attribute__((ext_vector_type(4)));
typedef unsigned u32x4 __attribute__((ext_vector_type(4)));
constexpr int BM = 256, BK = 64, HALF = 128, HTB = HALF * BK * 2  , STAGE_BYTES = 8 * HTB, NXCD = 8, WGM = 8;

__host__ __device__ __forceinline__ int lds_byte(int r, int c) { const int st = (r >> 4) * 2 + (c >> 5), rr = r & 15, cc = c & 31, ob = rr * 64 + cc * 2; return st * 1024 + (ob ^ (((ob >> 9) & 1) << 5)); }
__host__ __device__ __forceinline__ void stage_rc(int b, int& R, int& C) { const int st = b / 1024, sb = b % 1024, swz = sb ^ (((sb >> 9) & 1) << 5); R = (st >> 1) * 16 + swz / 64; C = (st & 1) * 32 + (swz % 64) / 2; }
__host__ __device__ __forceinline__ int perm32(int rho) { const int n = rho >> 4, i = rho & 15; return 8 * (i >> 2) + 4 * n + (i & 3); }

struct Unit { int pm, pn; };
struct Gemm { const bf16_t* A; const bf16_t* Bt; int M, N, K; };

struct StaticOrder {
    int nM, nN, nwg, G, c;
    __host__ __device__ void init(int M, int N, int G_, int c_) { nM = M / BM; nN = N / BM; nwg = nM * nN; G = G_; c = c_; }
    __host__ __device__ bool next(int i, Unit& u) const {
        const long L = (long)i * G + c; if (L >= nwg) return false;
        int wgid = (int)L; { const int q = nwg / NXCD, r = nwg % NXCD, xcd = wgid % NXCD, off = wgid / NXCD; wgid = (xcd < r ? xcd * (q + 1) : r * (q + 1) + (xcd - r) * q) + off; }
        const int nig = WGM * nN, gid = wgid / nig, fm = gid * WGM, gsz = (nM - fm) < WGM ? (nM - fm) : WGM;
        u.pm = fm + ((wgid % nig) % gsz); u.pn = (wgid % nig) / gsz; return true;
    }
    __device__ __forceinline__ void a_ready(const Unit&) const {}
    __device__ __forceinline__ void done(const Unit&) const {}
};

__device__ __forceinline__ unsigned cvt_pk_bf16(float lo, float hi) { unsigned r; asm volatile("v_cvt_pk_bf16_f32 %0, %1, %2" : "=v"(r) : "v"(lo), "v"(hi)); return r; }
typedef float f32x2z __attribute__((ext_vector_type(2)));
__device__ __forceinline__ f32x4 zero4() { f32x2z lo, hi; asm volatile("v_pk_mov_b32 %0, 0, 0" : "=v"(lo)); asm volatile("v_pk_mov_b32 %0, 0, 0" : "=v"(hi)); return (f32x4){lo[0], lo[1], hi[0], hi[1]}; }
typedef unsigned u32x2 __attribute__((ext_vector_type(2)));
constexpr float RMS_EPS = 1e-6f, INV_D = 1.0f / 1024.0f;
__device__ __forceinline__ float silu_mul(float g, float u) { return g * __builtin_amdgcn_rcpf(1.0f + __builtin_amdgcn_exp2f(g * -1.44269504089f)) * u; }
struct NoCvt { __device__ __forceinline__ void load(int) {} __device__ __forceinline__ void mid() {} __device__ __forceinline__ void finish() {} };
template <class Cvt> struct EpiSwiglu {
    static constexpr bool PERM = true, AFTER_DRAIN = false;
    static constexpr bool NEEDS_SCALE = true;
    bf16_t* O; int ldc; const float* rowss; Cvt cvt0;
    __device__ __forceinline__ void operator()(const f32x4 (&acc)[2][2][4][2], const Unit& u, int wr, int wc, int fr, int fq, const PG8_LAS float* stab, int ui) const {
        Cvt cvt = cvt0; cvt.load(ui);
        const int row0 = u.pm * BM + wr * 64 + fr, col0 = u.pn * HALF + wc * 32 + 8 * fq;
        float sv[2][4];
#pragma unroll
        for (int ai = 0; ai < 2; ++ai)
#pragma unroll
            for (int m = 0; m < 4; ++m) sv[ai][m] = stab ? stab[wr * 64 + fr + ai * HALF + m * 16] : __builtin_amdgcn_rsqf(rowss[u.pm * BM + wr * 64 + fr + ai * HALF + m * 16] * INV_D + RMS_EPS);
#pragma unroll
        for (int ai = 0; ai < 2; ++ai) {
#pragma unroll
            for (int m = 0; m < 4; ++m) { const int row = row0 + ai * HALF + m * 16; const float s = sv[ai][m];
                const float c = s * -1.44269504089f, is2 = __builtin_amdgcn_rcpf(s * s); f32x4 o[2];
#pragma unroll
                for (int n = 0; n < 2; ++n) { const f32x4 g = acc[ai][0][m][n], uu = acc[ai][1][m][n]; const f32x4 t = g * c; f32x4 e;
                    e[0] = __builtin_amdgcn_exp2f(t[0]); e[1] = __builtin_amdgcn_exp2f(t[1]); e[2] = __builtin_amdgcn_exp2f(t[2]); e[3] = __builtin_amdgcn_exp2f(t[3]);
                    const f32x4 d = e * is2 + is2; f32x4 r; r[0] = __builtin_amdgcn_rcpf(d[0]); r[1] = __builtin_amdgcn_rcpf(d[1]); r[2] = __builtin_amdgcn_rcpf(d[2]); r[3] = __builtin_amdgcn_rcpf(d[3]);
                    o[n] = (g * uu) * r; }
                u32x4 w; w.x = cvt_pk_bf16(o[0][0], o[0][1]); w.y = cvt_pk_bf16(o[0][2], o[0][3]); w.z = cvt_pk_bf16(o[1][0], o[1][1]); w.w = cvt_pk_bf16(o[1][2], o[1][3]);
                *(u32x4*)(O + (size_t)row * ldc + col0) = w; asm volatile("" ::: "memory"); }
            if (ai == 0) cvt.mid(); }
        cvt.finish();
    }
};
struct EpiRowScale {
    static constexpr bool PERM = true, AFTER_DRAIN = false;
    static constexpr bool NEEDS_SCALE = true;
    bf16_t* O; int ldc; const float* rowss;
    __device__ __forceinline__ void operator()(const f32x4 (&acc)[2][2][4][2], const Unit& u, int wr, int wc, int fr, int fq, const PG8_LAS float* stab, int ui) const {
        const int row0 = u.pm * BM + wr * 64 + fr, col0 = u.pn * BM + wc * 32 + 8 * fq;
        float sv[2][4];
#pragma unroll
        for (int ai = 0; ai < 2; ++ai)
#pragma unroll
            for (int m = 0; m < 4; ++m) sv[ai][m] = stab ? stab[wr * 64 + fr + ai * HALF + m * 16] : __builtin_amdgcn_rsqf(rowss[u.pm * BM + wr * 64 + fr + ai * HALF + m * 16] * INV_D + RMS_EPS);
#pragma unroll
        for (int ai = 0; ai < 2; ++ai)
#pragma unroll
            for (int m = 0; m < 4; ++m) { const int row = row0 + ai * HALF + m * 16; const float s = sv[ai][m];
#pragma unroll
                for (int bj = 0; bj < 2; ++bj) { const f32x4 v0 = acc[ai][bj][m][0] * s, v1 = acc[ai][bj][m][1] * s;
                    u32x4 w; w.x = cvt_pk_bf16(v0[0], v0[1]); w.y = cvt_pk_bf16(v0[2], v0[3]); w.z = cvt_pk_bf16(v1[0], v1[1]); w.w = cvt_pk_bf16(v1[2], v1[3]);
                    *(u32x4*)(O + (size_t)row * ldc + col0 + bj * HALF) = w; } asm volatile("" ::: "memory"); }
    }
};
struct EpiResid {
    static constexpr bool PERM = true, AFTER_DRAIN = false;
    static constexpr bool NEEDS_SCALE = false;
    bf16_t* xb; float* rowss_out; float alpha;
    __device__ __forceinline__ void operator()(const f32x4 (&acc)[2][2][4][2], const Unit& u, int wr, int wc, int fr, int fq, const PG8_LAS float*, int) const {
        const int row0 = u.pm * BM + wr * 64 + fr, col0 = u.pn * BM + wc * 32 + 8 * fq;
        bf16_t* p0 = xb + (size_t)row0 * 1024 + col0;
        u32x4 pre[2][4][2];
#pragma unroll
        for (int ai = 0; ai < 2; ++ai)
#pragma unroll
            for (int m = 0; m < 4; ++m)
#pragma unroll
                for (int bj = 0; bj < 2; ++bj) pre[ai][m][bj] = *(const u32x4*)(p0 + (size_t)(ai * HALF + m * 16) * 1024 + bj * HALF);
        asm volatile("" ::: "memory");
#pragma unroll
        for (int ai = 0; ai < 2; ++ai)
#pragma unroll
            for (int m = 0; m < 4; ++m) { f32x4 ssv = {0.f, 0.f, 0.f, 0.f};
#pragma unroll
                for (int bj = 0; bj < 2; ++bj) { const u32x4 b = pre[ai][m][bj];
                    f32x4 b0, b1; b0[0] = __uint_as_float(b.x << 16); b0[1] = __uint_as_float(b.x & 0xffff0000u); b0[2] = __uint_as_float(b.y << 16); b0[3] = __uint_as_float(b.y & 0xffff0000u);
                    b1[0] = __uint_as_float(b.z << 16); b1[1] = __uint_as_float(b.z & 0xffff0000u); b1[2] = __uint_as_float(b.w << 16); b1[3] = __uint_as_float(b.w & 0xffff0000u);
                    const f32x4 o0 = acc[ai][bj][m][0] * alpha + b0, o1 = acc[ai][bj][m][1] * alpha + b1;
                    ssv = o0 * o0 + ssv; ssv = o1 * o1 + ssv;
                    u32x4 w; w.x = cvt_pk_bf16(o0[0], o0[1]); w.y = cvt_pk_bf16(o0[2], o0[3]); w.z = cvt_pk_bf16(o1[0], o1[1]); w.w = cvt_pk_bf16(o1[2], o1[3]);
                    *(u32x4*)(p0 + (size_t)(ai * HALF + m * 16) * 1024 + bj * HALF) = w; }
                float ss = (ssv[0] + ssv[1]) + (ssv[2] + ssv[3]);
                ss += __shfl_xor(ss, 16); ss += __shfl_xor(ss, 32);
                if (fq == 0) unsafeAtomicAdd(rowss_out + row0 + ai * HALF + m * 16, ss); }
    }
};
template <class Epi, class Sched, bool ALIGN_EPI = false, bool SP2 = false>
__device__ __forceinline__ void gemm_phase(PG8_LAS unsigned char* lds, const Gemm g, const Sched& S, const Epi& E) {
    int tid_ = threadIdx.x; asm volatile("" : "+v"(tid_));
    const int tid = tid_, wid = __builtin_amdgcn_readfirstlane(tid >> 6), lane = tid & 63, wr = wid >> 2, wc = wid & 3, fr = lane & 15, fq = lane >> 4;
    const int K = g.K, nt = K / BK;
    PG8_LAS float* const stab = (PG8_LAS float*)(lds + STAGE_BYTES + 1024);
    unsigned voffA[2], voffB[2];
#pragma unroll
    for (int i = 0; i < 2; ++i) { int R, C; stage_rc(tid * 16 + i * 8192, R, C); const int Rb = Epi::PERM ? ((R & ~31) + perm32(R & 31)) : R;
        voffA[i] = (unsigned)(R * K + C) * 2u; voffB[i] = (unsigned)(Rb * K + C) * 2u; }
    const size_t kstep = (size_t)(BK * 2);
    const size_t hstep = (size_t)HALF * K * 2;
    const size_t tstep = 2 * hstep;
    const unsigned ldsw = (unsigned)wid * 1024u;
    const int aoff = lds_byte(wr * 64 + fr, fq * 8), boff = lds_byte(wc * 32 + fr, fq * 8);
#define PG8_SA(b, h) (((b) * 2 + (h)) * HTB)
#define PG8_SB(b, h) ((4 + (b) * 2 + (h)) * HTB)
#define PG8_STAGE(bufoff, gbase, voff) do { _Pragma("unroll") for (int _i = 0; _i < 2; ++_i) \
        __builtin_amdgcn_global_load_lds((const unsigned*)((const char*)(gbase) + (voff)[_i]), (PG8_LAS unsigned*)(lds + (bufoff) + ldsw + _i * 8192), 16, 0, 0); } while (0)
#define PG8_LDA(dst, b, h) do { _Pragma("unroll") for (int m = 0; m < 4; ++m) _Pragma("unroll") for (int k = 0; k < 2; ++k) dst[m][k] = *(const PG8_LAS bf16x8*)(lds + PG8_SA(b, h) + aoff + m * 2048 + k * 1024); } while (0)
#define PG8_LDB(dst, b, h) do { _Pragma("unroll") for (int n = 0; n < 2; ++n) _Pragma("unroll") for (int k = 0; k < 2; ++k) dst[n][k] = *(const PG8_LAS bf16x8*)(lds + PG8_SB(b, h) + boff + n * 2048 + k * 1024); } while (0)
#define PG8_MMA(ai, bj, At, Bt) do { __builtin_amdgcn_s_setprio(1); _Pragma("unroll") for (int m = 0; m < 4; ++m) _Pragma("unroll") for (int n = 0; n < 2; ++n) _Pragma("unroll") for (int k = 0; k < 2; ++k) \
        acc[ai][bj][m][n] = __builtin_amdgcn_mfma_f32_16x16x32_bf16(Bt[n][k], At[m][k], acc[ai][bj][m][n], 0, 0, 0); __builtin_amdgcn_s_setprio(0); } while (0)
#define PG8_WAIT_V(n) asm volatile("s_waitcnt vmcnt(" #n ")" ::: "memory")
#define PG8_WAIT_L(n) asm volatile("s_waitcnt lgkmcnt(" #n ")" ::: "memory")
#define PG8_BAR __builtin_amdgcn_s_barrier()
#define PG8_SCHED __builtin_amdgcn_sched_barrier(0)
    Unit cur, nxt; int ui = 0;
    if (!S.next(0, cur)) return;
    f32x4 acc[2][2][4][2];
#pragma unroll
    for (int a = 0; a < 2; ++a)
#pragma unroll
        for (int b = 0; b < 2; ++b)
#pragma unroll
            for (int m = 0; m < 4; ++m)
#pragma unroll
                for (int n = 0; n < 2; ++n) acc[a][b][m][n] = zero4();
    bf16x8 At[4][2], B0[2][2], B1[2][2];
    const char* cA = (const char*)g.A + (size_t)cur.pm * tstep; const char* cB = (const char*)g.Bt + (size_t)cur.pn * tstep;
    S.a_ready(cur);
    if constexpr (SP2) {
        PG8_STAGE(PG8_SB(0, 0), cB, voffB); PG8_STAGE(PG8_SB(0, 1), cB + hstep, voffB); PG8_STAGE(PG8_SA(0, 0), cA, voffA); PG8_STAGE(PG8_SA(0, 1), cA + hstep, voffA);
        if constexpr (Epi::NEEDS_SCALE) { Unit tu;
        for (int i = 0; i < 12 && S.next(i, tu); ++i) if (tid < 256) stab[i * 256 + tid] = __builtin_amdgcn_rsqf(E.rowss[tu.pm * BM + tid] * INV_D + RMS_EPS);
        asm volatile("s_waitcnt vmcnt(0) lgkmcnt(0)" ::: "memory"); }
        if (wr == 1) PG8_BAR;
        PG8_WAIT_V(2); PG8_BAR;
        PG8_STAGE(PG8_SB(1, 0), cB + kstep, voffB); PG8_STAGE(PG8_SA(1, 0), cA + kstep, voffA); PG8_STAGE(PG8_SB(1, 1), cB + hstep + kstep, voffB);
        PG8_WAIT_V(6); PG8_BAR;
    } else {
        PG8_STAGE(PG8_SB(0, 0), cB, voffB); PG8_STAGE(PG8_SA(0, 0), cA, voffA); PG8_STAGE(PG8_SB(0, 1), cB + hstep, voffB); PG8_STAGE(PG8_SA(0, 1), cA + hstep, voffA);
        if constexpr (Epi::NEEDS_SCALE) { Unit tu;
        for (int i = 0; i < 12 && S.next(i, tu); ++i) if (tid < 256) stab[i * 256 + tid] = __builtin_amdgcn_rsqf(E.rowss[tu.pm * BM + tid] * INV_D + RMS_EPS);
        asm volatile("s_waitcnt vmcnt(0) lgkmcnt(0)" ::: "memory"); }
        if (wr == 1) PG8_BAR;
        PG8_WAIT_V(4); PG8_BAR;
        PG8_STAGE(PG8_SB(1, 0), cB + kstep, voffB); PG8_STAGE(PG8_SA(1, 0), cA + kstep, voffA); PG8_STAGE(PG8_SB(1, 1), cB + hstep + kstep, voffB);
        PG8_WAIT_V(6); PG8_BAR;
    }
    for (;;) {
        const bool has_next = S.next(ui + 1, nxt);
        const char* nA = has_next ? (const char*)g.A + (size_t)nxt.pm * tstep : cA; const char* nB = has_next ? (const char*)g.Bt + (size_t)nxt.pn * tstep : cB;
        for (int t = 0; t < nt; t += 2) {
            const bool last = (t == nt - 2);
            const char* a1 = cA + (size_t)(t + 1) * kstep;
            const char* a2 = last ? nA : cA + (size_t)(t + 2) * kstep; const char* b2 = last ? nB : cB + (size_t)(t + 2) * kstep;
            const char* a3 = a2 + kstep; const char* b3 = b2 + kstep;
            if (last && has_next) S.a_ready(nxt);
            if constexpr (SP2) {
            PG8_LDB(B0, 0, 0); PG8_LDB(B1, 0, 1); PG8_SCHED; PG8_LDA(At, 0, 0); PG8_STAGE(PG8_SA(1, 1), a1 + hstep, voffA);
            PG8_WAIT_V(8); PG8_WAIT_L(0); PG8_BAR; PG8_MMA(0, 0, At, B0); PG8_MMA(0, 1, At, B1); PG8_BAR; PG8_SCHED;
            PG8_LDA(At, 0, 1); PG8_STAGE(PG8_SB(0, 0), b2, voffB); PG8_STAGE(PG8_SB(0, 1), b2 + hstep, voffB); PG8_STAGE(PG8_SA(0, 0), a2, voffA);
            PG8_WAIT_V(8); PG8_WAIT_L(0); PG8_BAR; PG8_MMA(1, 0, At, B0); PG8_MMA(1, 1, At, B1); PG8_BAR; PG8_SCHED;
            PG8_LDB(B0, 1, 0); PG8_LDB(B1, 1, 1); PG8_SCHED; PG8_LDA(At, 1, 0); PG8_STAGE(PG8_SA(0, 1), a2 + hstep, voffA);
            PG8_WAIT_V(8); PG8_WAIT_L(0); PG8_BAR; PG8_MMA(0, 0, At, B0); PG8_MMA(0, 1, At, B1); PG8_BAR; PG8_SCHED;
            PG8_LDA(At, 1, 1); PG8_STAGE(PG8_SB(1, 0), b3, voffB); PG8_STAGE(PG8_SB(1, 1), b3 + hstep, voffB); PG8_STAGE(PG8_SA(1, 0), a3, voffA);
            PG8_WAIT_V(8); PG8_WAIT_L(0); PG8_BAR; PG8_MMA(1, 0, At, B0); PG8_MMA(1, 1, At, B1); PG8_BAR; PG8_SCHED;
            } else {
            PG8_LDB(B0, 0, 0); PG8_SCHED; PG8_LDA(At, 0, 0); PG8_STAGE(PG8_SA(1, 1), a1 + hstep, voffA);
            PG8_WAIT_L(8); PG8_BAR; PG8_WAIT_L(0); PG8_MMA(0, 0, At, B0); PG8_BAR; PG8_SCHED;
            PG8_LDB(B1, 0, 1); PG8_STAGE(PG8_SB(0, 0), b2, voffB);
            PG8_BAR; PG8_WAIT_L(0); PG8_MMA(0, 1, At, B1); PG8_BAR;
            PG8_LDA(At, 0, 1); PG8_STAGE(PG8_SA(0, 0), a2, voffA);
            PG8_BAR; PG8_WAIT_L(0); PG8_MMA(1, 0, At, B0); PG8_BAR; PG8_SCHED;
            PG8_STAGE(PG8_SB(0, 1), b2 + hstep, voffB);
            PG8_WAIT_V(6); PG8_BAR; PG8_MMA(1, 1, At, B1); PG8_BAR;
            PG8_LDB(B0, 1, 0); PG8_SCHED; PG8_LDA(At, 1, 0); PG8_STAGE(PG8_SA(0, 1), a2 + hstep, voffA);
            PG8_WAIT_L(8); PG8_BAR; PG8_WAIT_L(0); PG8_MMA(0, 0, At, B0); PG8_BAR; PG8_SCHED;
            PG8_LDB(B1, 1, 1); PG8_STAGE(PG8_SB(1, 0), b3, voffB);
            PG8_BAR; PG8_WAIT_L(0); PG8_MMA(0, 1, At, B1); PG8_BAR;
            PG8_LDA(At, 1, 1); PG8_STAGE(PG8_SA(1, 0), a3, voffA);
            PG8_BAR; PG8_WAIT_L(0); PG8_MMA(1, 0, At, B0); PG8_BAR; PG8_SCHED;
            PG8_STAGE(PG8_SB(1, 1), b3 + hstep, voffB);
            PG8_WAIT_V(6); PG8_BAR; PG8_MMA(1, 1, At, B1); PG8_BAR;
            }
        }
        if constexpr (ALIGN_EPI) { if (wr == 0) PG8_BAR; }
        if constexpr (!Epi::AFTER_DRAIN) { E(acc, cur, wr, wc, fr, fq, ui < 12 ? stab + ui * 256 : (const PG8_LAS float*)nullptr, ui); S.done(cur); }
        if (!has_next) break;
#pragma unroll
        for (int a = 0; a < 2; ++a)
#pragma unroll
            for (int b = 0; b < 2; ++b)
#pragma unroll
                for (int m = 0; m < 4; ++m)
#pragma unroll
                    for (int n = 0; n < 2; ++n) acc[a][b][m][n] = zero4();
        cur = nxt; cA = nA; cB = nB; ++ui;
        if constexpr (ALIGN_EPI) { if (wr == 1) PG8_BAR; }
    }
    PG8_WAIT_V(0);
    if constexpr (!ALIGN_EPI) { if (wr == 0) PG8_BAR; }
    PG8_BAR;
    if constexpr (Epi::AFTER_DRAIN) { E.fused(acc, cur, wr, wc, fr, fq, lds, wid, lane); S.done(cur); }
#undef PG8_SA
#undef PG8_SB
#undef PG8_STAGE
#undef PG8_LDA
#undef PG8_LDB
#undef PG8_MMA
#undef PG8_WAIT_V
#undef PG8_WAIT_L
#undef PG8_BAR
#undef PG8_SCHED
}
}

constexpr int NB = 4, SEQ = 8192, DM = 1024, FF = 2816, T = NB * SEQ, INW = 2304, HD = 64;
constexpr size_t MiB = 1u << 20;
constexpr size_t SZ_GU = (size_t)2 * FF * DM * 2, SZ_D = (size_t)DM * FF * 2, SZ_IN = (size_t)INW * DM * 2, SZ_OUT = (size_t)DM * DM * 2;
constexpr size_t OFF_GU1 = 0, OFF_D1 = OFF_GU1 + SZ_GU, OFF_IN = OFF_D1 + SZ_D, OFF_OUT = OFF_IN + SZ_IN, OFF_GU2 = OFF_OUT + SZ_OUT, OFF_D2 = OFF_GU2 + SZ_GU, SZ_LAYER = OFF_D2 + SZ_D;
constexpr size_t WS_ROWSS = 0;
constexpr size_t WS_W = 1 * MiB;
constexpr size_t WS_XB = 81 * MiB;
constexpr size_t WS_ACT = 145 * MiB;
constexpr size_t WS_Z = WS_ACT;
constexpr int ZP = FF;
constexpr size_t WS_MIX = 321 * MiB;
constexpr size_t WS_BAR = 385 * MiB;
constexpr size_t WS_END = 386 * MiB;
static_assert(WS_W + 2 * SZ_LAYER <= WS_XB && WS_XB + (size_t)T * DM * 2 <= WS_ACT && WS_ACT + (size_t)T * FF * 2 <= WS_MIX && WS_MIX + (size_t)T * DM * 2 <= WS_BAR, "ws map");
constexpr int LDS_BYTES = 147456;

#define GAS __attribute__((address_space(1)))
#define LAS __attribute__((address_space(3)))
typedef unsigned short bf16;
typedef unsigned v4u __attribute__((ext_vector_type(4)));
typedef unsigned v2u __attribute__((ext_vector_type(2)));
typedef float f32x4 __attribute__((ext_vector_type(4)));
typedef float f32x8 __attribute__((ext_vector_type(8)));
typedef float f32x16 __attribute__((ext_vector_type(16)));
typedef short bf16x8 __attribute__((ext_vector_type(8)));
typedef short s16x4 __attribute__((ext_vector_type(4)));
#define LDS_WAIT() asm volatile("s_waitcnt lgkmcnt(0)" ::: "memory")
using pg8::cvt_pk_bf16;

__device__ __forceinline__ float wave_sum(float v) {
#pragma unroll
    for (int o = 1; o < 64; o <<= 1) v += __shfl_xor(v, o);
    return v;
}
struct Args { const float* in[15]; float* out; unsigned char* ws; };
constexpr int I_G = (DM / 64) * (FF / 64), I_D = (FF / 64) * (DM / 64), I_IN = (DM / 64) * (INW / 64), I_OUT = (DM / 64) * (DM / 64);
constexpr int I_LAYER = 4 * I_G + 2 * I_D + I_IN + I_OUT;
constexpr int I_FIRST = 2 * I_G;
constexpr int I_REST = 2 * I_LAYER - I_FIRST;
struct CvtItem {
    f32x4 v[2][8]; const float* gain; bf16* dst; int K, k8; bool on;
    template <bool ISSUE = true> __device__ __forceinline__ void load_item(const Args& a, int l, int r, int lane) {
        unsigned char* wl = a.ws + WS_W + (size_t)l * SZ_LAYER; const size_t lg = (size_t)l * DM * FF;
        const float* W; int N, mode; const float* g = nullptr; bf16* WT; K = DM;
        if (r < I_G) { W = a.in[2] + lg; N = FF; g = a.in[1] + l * DM; WT = (bf16*)(wl + OFF_GU1); mode = 1; }
        else if ((r -= I_G) < I_G) { W = a.in[3] + lg; N = FF; g = a.in[1] + l * DM; WT = (bf16*)(wl + OFF_GU1); mode = 2; }
        else if ((r -= I_G) < I_D) { W = a.in[4] + lg; N = DM; K = FF; WT = (bf16*)(wl + OFF_D1); mode = 0; }
        else if ((r -= I_D) < I_IN) { W = a.in[6] + (size_t)l * DM * INW; N = INW; g = a.in[5] + l * DM; WT = (bf16*)(wl + OFF_IN); mode = 0; }
        else if ((r -= I_IN) < I_OUT) { W = a.in[9] + (size_t)l * DM * DM; N = DM; WT = (bf16*)(wl + OFF_OUT); mode = 0; }
        else if ((r -= I_OUT) < I_G) { W = a.in[11] + lg; N = FF; g = a.in[10] + l * DM; WT = (bf16*)(wl + OFF_GU2); mode = 1; }
        else if ((r -= I_G) < I_G) { W = a.in[12] + lg; N = FF; g = a.in[10] + l * DM; WT = (bf16*)(wl + OFF_GU2); mode = 2; }
        else { r -= I_G; W = a.in[13] + lg; N = DM; K = FF; WT = (bf16*)(wl + OFF_D2); mode = 0; }
        const int nblk = N / 64, kb = r / nblk, nb = r % nblk, k0 = 64 * kb, n0 = 64 * nb, j = lane >> 3, q = lane & 7;
        const float* src = W + (size_t)(k0 + 8 * j) * N + n0 + 4 * q; src_ = src; N_ = N;
        if constexpr (ISSUE) {
#pragma unroll
        for (int hh = 0; hh < 2; ++hh)
#pragma unroll
            for (int i = 0; i < 8; ++i) v[hh][i] = __builtin_nontemporal_load((const f32x4*)(src + (size_t)i * N + 32 * hh)); }
        const int r0 = (mode == 0) ? n0 : (256 * (n0 / 128) + (n0 % 128) + (mode == 2 ? 128 : 0));
        dst = WT + (size_t)(r0 + 4 * q) * K + k0 + 8 * j; k8 = k0 + 8 * j; gain = g;
    }
    const float* src_; int N_;
    __device__ __forceinline__ void load_half(int hh) {
#pragma unroll
        for (int i = 0; i < 8; ++i) v[0][i] = __builtin_nontemporal_load((const f32x4*)(src_ + (size_t)i * N_ + 32 * hh));
    }
    __device__ __forceinline__ void finish_half(int hh) {
        if (gain) { const f32x4 g0 = *(const f32x4*)(gain + k8), g1 = *(const f32x4*)(gain + k8 + 4);
            v[0][0] *= g0[0]; v[0][1] *= g0[1]; v[0][2] *= g0[2]; v[0][3] *= g0[3]; v[0][4] *= g1[0]; v[0][5] *= g1[1]; v[0][6] *= g1[2]; v[0][7] *= g1[3]; }
#pragma unroll
        for (int nn = 0; nn < 4; ++nn) { v4u o; o.x = cvt_pk_bf16(v[0][0][nn], v[0][1][nn]); o.y = cvt_pk_bf16(v[0][2][nn], v[0][3][nn]); o.z = cvt_pk_bf16(v[0][4][nn], v[0][5][nn]); o.w = cvt_pk_bf16(v[0][6][nn], v[0][7][nn]);
            *(v4u*)(dst + (size_t)(32 * hh + nn) * K) = o; }
    }
    __device__ __forceinline__ void finish_item() {
        if (gain) { const f32x4 g0 = *(const f32x4*)(gain + k8), g1 = *(const f32x4*)(gain + k8 + 4);
#pragma unroll
            for (int hh = 0; hh < 2; ++hh) { v[hh][0] *= g0[0]; v[hh][1] *= g0[1]; v[hh][2] *= g0[2]; v[hh][3] *= g0[3]; v[hh][4] *= g1[0]; v[hh][5] *= g1[1]; v[hh][6] *= g1[2]; v[hh][7] *= g1[3]; } }
#pragma unroll
        for (int hh = 0; hh < 2; ++hh)
#pragma unroll
            for (int nn = 0; nn < 4; ++nn) { v4u o; o.x = cvt_pk_bf16(v[hh][0][nn], v[hh][1][nn]); o.y = cvt_pk_bf16(v[hh][2][nn], v[hh][3][nn]); o.z = cvt_pk_bf16(v[hh][4][nn], v[hh][5][nn]); o.w = cvt_pk_bf16(v[hh][6][nn], v[hh][7][nn]);
                *(v4u*)(dst + (size_t)(32 * hh + nn) * K) = o; }
    }
};
struct CvtRest {
    const Args* a; CvtItem it;
    __device__ __forceinline__ void load(int ui) {
        const int lane = threadIdx.x & 63, gw = blockIdx.x * 8 + __builtin_amdgcn_readfirstlane(threadIdx.x >> 6), NGW = gridDim.x * 8;
        const int j = ui * NGW + (NGW - 1 - gw); it.on = j < I_REST;
        if (it.on) { const int jj = j + I_FIRST; it.load_item<false>(*a, jj / I_LAYER, jj % I_LAYER, lane); it.load_half(0); }
    }
    __device__ __forceinline__ void mid() { if (it.on) { it.finish_half(0); it.load_half(1); } }
    __device__ __forceinline__ void finish() { if (it.on) it.finish_half(1); }
};

__device__ __forceinline__ void p0_prologue(const Args& a) {
    int tid_ = threadIdx.x; asm volatile("" : "+v"(tid_));
    const int tid = tid_, lane = tid & 63, wave = tid >> 6;
    const int gw = blockIdx.x * 8 + wave, NGW = gridDim.x * 8;
    for (int it = NGW - 1 - gw; it < I_FIRST; it += NGW) { CvtItem c; c.load_item(a, 0, it, lane); c.finish_item(); }
    float* rowss = (float*)(a.ws + WS_ROWSS); bf16* XB = (bf16*)(a.ws + WS_XB);
    for (int m = gw * 4; m < T; m += NGW * 4) { const f32x4* xr = (const f32x4*)(a.in[0] + (size_t)m * DM) + lane; f32x4 v[4][4];
#pragma unroll
        for (int rr = 0; rr < 4; ++rr)
#pragma unroll
            for (int j = 0; j < 4; ++j) v[rr][j] = __builtin_nontemporal_load(xr + rr * 256 + 64 * j);
#pragma unroll
        for (int rr = 0; rr < 4; ++rr) { float s = 0.f;
#pragma unroll
            for (int j = 0; j < 4; ++j) s += (v[rr][j].x * v[rr][j].x + v[rr][j].y * v[rr][j].y) + (v[rr][j].z * v[rr][j].z + v[rr][j].w * v[rr][j].w);
            s = wave_sum(s); if (lane == 0) rowss[m + rr] = s;
            v2u* o8 = (v2u*)(XB + (size_t)(m + rr) * DM) + lane;
#pragma unroll
            for (int j = 0; j < 4; ++j) { v2u w; w.x = cvt_pk_bf16(v[rr][j].x, v[rr][j].y); w.y = cvt_pk_bf16(v[rr][j].z, v[rr][j].w); o8[64 * j] = w; } } }
    for (int i = blockIdx.x * 512 + tid; i < 7 * T; i += gridDim.x * 512) rowss[T + i] = 0.f;
}

__device__ __forceinline__ void final_norm(const Args& a) {
    int tid_ = threadIdx.x; asm volatile("" : "+v"(tid_));
    const int tid = tid_, lane = tid & 63, wave = tid >> 6; const int gw = blockIdx.x * 8 + wave, NGW = gridDim.x * 8;
    const float* rowss = (const float*)(a.ws + WS_ROWSS) + 6 * T; const bf16* XB = (const bf16*)(a.ws + WS_XB);
    f32x4 g[4];
#pragma unroll
    for (int j = 0; j < 4; ++j) g[j] = ((const f32x4*)a.in[14])[lane + 64 * j];
    const bool quad = (gridDim.x == 256); const int qx = blockIdx.x & 7, qp = (blockIdx.x >> 3) & 7, qk = blockIdx.x >> 6;
    const int m_lo = quad ? 256 * (16 * qx + qp + 8 * (qk >> 1)) + 128 * (qk & 1) + 16 * wave : gw * 4, m_hi = quad ? m_lo + 16 : T, m_st = quad ? 4 : NGW * 4;
    for (int m = m_lo; m < m_hi; m += m_st) { v2u v[4][4]; float s[4];
#pragma unroll
        for (int rr = 0; rr < 4; ++rr) { s[rr] = __builtin_amdgcn_rsqf(rowss[m + rr] * pg8::INV_D + pg8::RMS_EPS);
#pragma unroll
            for (int j = 0; j < 4; ++j) v[rr][j] = ((const v2u*)(XB + (size_t)(m + rr) * DM))[lane + 64 * j]; }
#pragma unroll
        for (int rr = 0; rr < 4; ++rr) { f32x4* o = (f32x4*)(a.out + (size_t)(m + rr) * DM) + lane;
#pragma unroll
            for (int j = 0; j < 4; ++j) { f32x4 x; x[0] = __uint_as_float(v[rr][j].x << 16); x[1] = __uint_as_float(v[rr][j].x & 0xffff0000u); x[2] = __uint_as_float(v[rr][j].y << 16); x[3] = __uint_as_float(v[rr][j].y & 0xffff0000u);
                __builtin_nontemporal_store(x * s[rr] * g[j], o + 64 * j); } } }
}

constexpr int KP = 72, VP = 260;
constexpr int ATT_K_OFF = 0, ATT_V_OFF = 256 * KP * 2;
__device__ __forceinline__ int crow(int r, int hi) { return (r & 3) + 8 * (r >> 2) + 4 * hi; }
__device__ __forceinline__ f32x8 bf8_to_f32(v4u v) { f32x8 o; o[0] = __uint_as_float(v.x << 16); o[1] = __uint_as_float(v.x & 0xffff0000u); o[2] = __uint_as_float(v.y << 16); o[3] = __uint_as_float(v.y & 0xffff0000u);
    o[4] = __uint_as_float(v.z << 16); o[5] = __uint_as_float(v.z & 0xffff0000u); o[6] = __uint_as_float(v.w << 16); o[7] = __uint_as_float(v.w & 0xffff0000u); return o; }

__device__ __forceinline__ void attn_conv_phase(LAS unsigned char* lds, const bf16* Z, bf16* MIX, const float* sink, const float* convw, bool quad) {
    int tid_ = threadIdx.x; asm volatile("" : "+v"(tid_));
    const int tid = tid_, lane = tid & 63, wid = tid >> 6, lq = lane & 31, hi = lane >> 5;
    constexpr float LOG2E = 1.44269504089f;
    const int u_first = quad ? 4 * (16 * (blockIdx.x & 7) + ((blockIdx.x >> 3) & 7) + 8 * (blockIdx.x >> 7)) + 2 * ((blockIdx.x >> 6) & 1) : blockIdx.x, u_step = quad ? 1 : gridDim.x, u_end = quad ? u_first + 2 : 512;
    for (int u = u_first; u < u_end; u += u_step) {
        const int kvh = u & 1, n = (u >> 1) & 63, b = u >> 7;
        const size_t rowb = (size_t)b * SEQ;
        v4u kreg[4], v0reg[2], v1reg[2];
#pragma unroll
        for (int jj = 0; jj < 4; ++jj) { const int c = tid + 512 * jj, key = c >> 3, part = c & 7;
            int t = n * 128 - 128 + key; if (t < 0) t = key;
            kreg[jj] = *(const v4u*)(Z + (rowb + t) * ZP + 512 + kvh * 64 + part * 8); }
#pragma unroll
        for (int jj = 0; jj < 2; ++jj) { const int c = tid + 512 * jj, kp = c >> 3, part = c & 7;
            int t = n * 128 - 128 + 2 * kp; if (t < 0) t = 2 * kp;
            const bf16* src = Z + (rowb + t) * ZP + 640 + kvh * 64 + part * 8;
            v0reg[jj] = *(const v4u*)src; v1reg[jj] = *(const v4u*)(src + ZP); }
        { const int c0 = (tid & 63) * 8, r0 = u * 64 + (tid >> 6) * 8, t0 = r0 & (SEQ - 1);
          const f32x8 w0 = *(const f32x8*)(convw + c0), w1 = *(const f32x8*)(convw + 512 + c0), w2 = *(const f32x8*)(convw + 1024 + c0);
          const int rlo = (t0 > 0) ? r0 - 2 : r0;
          v4u hc[2], hh[2];
#pragma unroll
          for (int i = 0; i < 2; ++i) { const bf16* zr = Z + (size_t)(rlo + i) * ZP; hc[i] = *(const v4u*)(zr + 1280 + c0); hh[i] = *(const v4u*)(zr + 1792 + c0); }
          f32x8 u2, u1;
#pragma unroll
          for (int hb = 0; hb < 2; ++hb) {
              v4u zc[4], zh[4], zb[4];
#pragma unroll
              for (int i = 0; i < 4; ++i) { const bf16* zr = Z + (size_t)(r0 + 4 * hb + i) * ZP; zb[i] = *(const v4u*)(zr + 768 + c0); zc[i] = *(const v4u*)(zr + 1280 + c0); zh[i] = *(const v4u*)(zr + 1792 + c0); }
              if (hb == 0) { u2 = bf8_to_f32(hc[0]) * bf8_to_f32(hh[0]); u1 = bf8_to_f32(hc[1]) * bf8_to_f32(hh[1]);
                  if (t0 == 0) {
#pragma unroll
                      for (int i = 0; i < 8; ++i) { u1[i] = 0.f; u2[i] = 0.f; } } }
#pragma unroll
              for (int i = 0; i < 4; ++i) { const f32x8 u0 = bf8_to_f32(zc[i]) * bf8_to_f32(zh[i]);
                  const f32x8 y = bf8_to_f32(zb[i]) * (w0 * u2 + w1 * u1 + w2 * u0);
                  v4u o; o.x = cvt_pk_bf16(y[0], y[1]); o.y = cvt_pk_bf16(y[2], y[3]); o.z = cvt_pk_bf16(y[4], y[5]); o.w = cvt_pk_bf16(y[6], y[7]);
                  *(v4u*)(MIX + (size_t)(r0 + 4 * hb + i) * DM + 512 + c0) = o; u2 = u1; u1 = u0; }
              asm volatile("" ::: "memory"); } }
#pragma unroll
        for (int jj = 0; jj < 4; ++jj) { const int c = tid + 512 * jj, key = c >> 3, part = c & 7;
            *(LAS v4u*)(lds + ATT_K_OFF + key * (KP * 2) + part * 16) = kreg[jj]; }
#pragma unroll
        for (int jj = 0; jj < 2; ++jj) { const int c = tid + 512 * jj, kp = c >> 3, part = c & 7; const v4u v0 = v0reg[jj], v1 = v1reg[jj];
            LAS unsigned* d = (LAS unsigned*)(lds + ATT_V_OFF) + (8 * part) * (VP / 2) + kp;
            d[0 * (VP / 2)] = (v0.x & 0xffffu) | (v1.x << 16); d[1 * (VP / 2)] = (v0.x >> 16) | (v1.x & 0xffff0000u);
            d[2 * (VP / 2)] = (v0.y & 0xffffu) | (v1.y << 16); d[3 * (VP / 2)] = (v0.y >> 16) | (v1.y & 0xffff0000u);
            d[4 * (VP / 2)] = (v0.z & 0xffffu) | (v1.z << 16); d[5 * (VP / 2)] = (v0.z >> 16) | (v1.z & 0xffff0000u);
            d[6 * (VP / 2)] = (v0.w & 0xffffu) | (v1.w << 16); d[7 * (VP / 2)] = (v0.w >> 16) | (v1.w & 0xffff0000u); }
        __syncthreads();
        for (int it = wid; it < 16; it += 8) {
            const int g = it >> 2, qc = it & 3, h = kvh * 4 + g, q0 = qc * 32;
            const size_t qrow = rowb + (size_t)n * 128 + q0 + lq;
            bf16x8 qf[4];
#pragma unroll
            for (int kc = 0; kc < 4; ++kc) qf[kc] = *(const bf16x8*)(Z + qrow * ZP + h * 64 + kc * 16 + 8 * hi);
            f32x16 st[5];
#pragma unroll
            for (int kt = 0; kt < 5; ++kt) {
#pragma unroll
                for (int r = 0; r < 16; ++r) st[kt][r] = 0.f;
#pragma unroll
                for (int kc = 0; kc < 4; ++kc) { const bf16x8 kf = *(const LAS bf16x8*)(lds + ATT_K_OFF + (q0 + 32 * kt + lq) * (KP * 2) + (kc * 16 + 8 * hi) * 2);
                    st[kt] = __builtin_amdgcn_mfma_f32_32x32x16_bf16(kf, qf[kc], st[kt], 0, 0, 0); } asm volatile("" ::: "memory"); }
            const float slope = __builtin_amdgcn_exp2f(-(float)(h + 1));
            const float c1 = 0.125f * LOG2E, c2 = slope * LOG2E, sk = sink[h] * LOG2E;
            const int a = lq - 4 * hi;
            const float lb = -c2 * (float)(a + 128);
            f32x16 b0;
#pragma unroll
            for (int r = 0; r < 16; ++r) b0[r] = c2 * (float)((r & 3) + 8 * (r >> 2)) + lb;
            float mx = sk;
#pragma unroll
            for (int kt = 0; kt < 5; ++kt) { st[kt] = st[kt] * c1 + b0;
                if (kt == 0) {
#pragma unroll
                    for (int r = 0; r < 16; ++r) st[kt][r] = ((r & 3) + 8 * (r >> 2) > a) ? st[kt][r] : -INFINITY; }
                if (kt == 4) {
#pragma unroll
                    for (int r = 0; r < 16; ++r) st[kt][r] = ((r & 3) + 8 * (r >> 2) <= a) ? st[kt][r] : -INFINITY; }
                if (n == 0) {
#pragma unroll
                    for (int r = 0; r < 16; ++r) st[kt][r] = (q0 + 32 * kt + crow(r, hi) >= 128) ? st[kt][r] : -INFINITY; }
                float m = st[kt][0];
#pragma unroll
                for (int r = 1; r < 16; ++r) m = fmaxf(m, st[kt][r]);
                mx = fmaxf(mx, m + c2 * (float)(32 * kt)); }
            mx = fmaxf(mx, __shfl_xor(mx, 32));
            float sum = 0.f;
#pragma unroll
            for (int kt = 0; kt < 5; ++kt) { const float sh = mx - c2 * (float)(32 * kt); st[kt] = st[kt] - sh;
#pragma unroll
                for (int r = 0; r < 16; ++r) { const float p = __builtin_amdgcn_exp2f(st[kt][r]); st[kt][r] = p; sum += p; } }
            sum += __shfl_xor(sum, 32); sum += __builtin_amdgcn_exp2f(sk - mx);
            const float inv = 1.0f / sum;
            f32x16 ot[2];
#pragma unroll
            for (int r = 0; r < 16; ++r) { ot[0][r] = 0.f; ot[1][r] = 0.f; }
#pragma unroll
            for (int kt = 0; kt < 5; ++kt)
#pragma unroll
                for (int c = 0; c < 2; ++c) {
                    v4u pw; pw.x = cvt_pk_bf16(st[kt][8 * c + 0], st[kt][8 * c + 1]); pw.y = cvt_pk_bf16(st[kt][8 * c + 2], st[kt][8 * c + 3]);
                    pw.z = cvt_pk_bf16(st[kt][8 * c + 4], st[kt][8 * c + 5]); pw.w = cvt_pk_bf16(st[kt][8 * c + 6], st[kt][8 * c + 7]);
                    const bf16x8 pf = __builtin_bit_cast(bf16x8, pw);
#pragma unroll
                    for (int dt = 0; dt < 2; ++dt) { const LAS unsigned char* vp = lds + ATT_V_OFF + ((dt * 32 + lq) * VP + (q0 + 32 * kt + 16 * c + 4 * hi)) * 2;
                        const v2u lo = *(const LAS v2u*)vp, hi2 = *(const LAS v2u*)(vp + 16);
                        v4u vv; vv.x = lo.x; vv.y = lo.y; vv.z = hi2.x; vv.w = hi2.y;
                        ot[dt] = __builtin_amdgcn_mfma_f32_32x32x16_bf16(__builtin_bit_cast(bf16x8, vv), pf, ot[dt], 0, 0, 0); } asm volatile("" ::: "memory"); }
            bf16* orow = MIX + qrow * DM + h * 64;
#pragma unroll
            for (int dt = 0; dt < 2; ++dt)
#pragma unroll
                for (int r4 = 0; r4 < 4; ++r4) { v2u w; w.x = cvt_pk_bf16(ot[dt][4 * r4 + 0] * inv, ot[dt][4 * r4 + 1] * inv); w.y = cvt_pk_bf16(ot[dt][4 * r4 + 2] * inv, ot[dt][4 * r4 + 3] * inv);
                    *(v2u*)(orow + dt * 32 + 8 * r4 + 4 * hi) = w; }
        }
        __syncthreads();
    }
}

#define RLX_AGENT __ATOMIC_RELAXED, __HIP_MEMORY_SCOPE_AGENT
#define XB_TMO      128
#define XB_XCNT(j)  (256  + 64 * (j))
#define XB_XSUB(j)  (1280 + 64 * (j))
#define XB_XGEN(j)  (2304 + 64 * (j))
#define XB_TOP      3328
#define XB_TOPGEN   3392
#define XCD_BAR_WORDS 3456
#define XB_SPIN_CAP (1u << 18)

__device__ __forceinline__ unsigned xb_ld(unsigned* p)              { return __hip_atomic_load(p, __ATOMIC_RELAXED, __HIP_MEMORY_SCOPE_AGENT); }
__device__ __forceinline__ unsigned xb_add(unsigned* p, unsigned v) { return __hip_atomic_fetch_add(p, v, __ATOMIC_RELAXED, __HIP_MEMORY_SCOPE_AGENT); }
__device__ __forceinline__ unsigned xb_xcc_id() { return (unsigned)__builtin_amdgcn_s_getreg((3 << 11) | 20) & 0xFu; }
#define XB_SPIN(cond, bar) do { unsigned _sp = 0; while (cond) { __builtin_amdgcn_s_sleep(1); \
    if ((++_sp & 255u) == 0u) { if (xb_ld(&(bar)[XB_TMO])) break; if (_sp > XB_SPIN_CAP) { atomicAdd(&(bar)[XB_TMO], 1u); break; } } } } while (0)

struct XcdBarrier {
    unsigned* bar; unsigned x;
    unsigned total;
    volatile LAS unsigned* st;
};

__device__ __forceinline__ XcdBarrier xcd_barrier_post(unsigned* bar, volatile LAS unsigned* st, unsigned total) {
    XcdBarrier b; b.bar = bar; b.x = xb_xcc_id(); b.st = st; b.total = total;
    if (threadIdx.x == 0) (void)xb_add(&bar[XB_XCNT(b.x)], 1u);
    return b;
}
__device__ __forceinline__ void xcd_barrier_complete(unsigned* bar, unsigned x, unsigned G, unsigned& nloc, unsigned& nx) {
    unsigned sum, cnt, mine, sp = 0u;
    for (;;) {
        sum = 0u; cnt = 0u; mine = 0u;
#pragma unroll
        for (unsigned j = 0; j < 16; ++j) { const unsigned c = xb_ld(&bar[XB_XCNT(j)]); sum += c; cnt += (c > 0u) ? 1u : 0u; mine = (j == x) ? c : mine; }
        if (sum == G) break;
        __builtin_amdgcn_s_sleep(1);
        if ((++sp & 255u) == 0u) { if (xb_ld(&bar[XB_TMO])) break; if (sp > XB_SPIN_CAP) { atomicAdd(&bar[XB_TMO], 1u); break; } }
    }
    nloc = mine > 0u ? mine : 1u; nx = cnt > 0u ? cnt : 1u;
}

__device__ __forceinline__ void xcd_barrier(const XcdBarrier& b) {
    asm volatile("s_waitcnt vmcnt(0)" ::: "memory");
    __syncthreads();
    if (threadIdx.x == 0) {
        unsigned* bar = b.bar;
        __builtin_amdgcn_s_waitcnt(0);
        unsigned nloc = b.st[0], nx = b.st[1];
        if (nloc == 0u) { xcd_barrier_complete(bar, b.x, b.total, nloc, nx); b.st[0] = nloc; b.st[1] = nx; }
        const unsigned old = xb_add(&bar[XB_XSUB(b.x)], 1u);
        const unsigned gen = old / nloc;
        if (old + 1u == (gen + 1u) * nloc) {
            __builtin_amdgcn_fence(__ATOMIC_RELEASE, "agent");
            asm volatile("s_waitcnt vmcnt(0)" ::: "memory");
            const unsigned og = xb_add(&bar[XB_TOP], 1u);
            const unsigned tg = og / nx;
            if (og + 1u == (tg + 1u) * nx) xb_add(&bar[XB_TOPGEN], 1u);
            else XB_SPIN(xb_ld(&bar[XB_TOPGEN]) == tg, bar);
            __builtin_amdgcn_fence(__ATOMIC_ACQUIRE, "agent");
            xb_add(&bar[XB_XGEN(b.x)], 1u);
            asm volatile("s_waitcnt vmcnt(0)" ::: "memory");
        } else {
            XB_SPIN(xb_ld(&bar[XB_XGEN(b.x)]) == gen, bar);
            __builtin_amdgcn_fence(__ATOMIC_ACQUIRE, "agent");
            asm volatile("s_waitcnt vmcnt(0)" ::: "memory");
        }
    }
    __syncthreads();
}

__device__ __forceinline__ void quad_barrier(unsigned* qbase, int q, int mode, unsigned ntarget) {
    asm volatile("s_waitcnt vmcnt(0)" ::: "memory");
    __syncthreads();
    if (threadIdx.x == 0) {
        unsigned* qw = qbase + 64 * q;
        const unsigned mask = xb_ld(qw + 1);
        bool rel = (mask & (mask - 1u)) != 0u;
        if (mode == 1) { const int x = q & 7, p = q >> 3;
            rel = rel || xb_ld(qbase + 64 * (p < 7 ? q + 8 : q - 56) + 1) != mask; if (p == 7 && x < 7) rel = rel || xb_ld(qbase + 64 * (q - 55) + 1) != mask; }
        if (rel) { __builtin_amdgcn_fence(__ATOMIC_RELEASE, "agent"); asm volatile("s_waitcnt vmcnt(0)" ::: "memory"); }
        const unsigned old = xb_add(qw, 1u), target = (old / 4u + 1u) * 4u; unsigned sp = 0u;
        while (xb_ld(qw) < target) { __builtin_amdgcn_s_sleep(1); if (++sp > XB_SPIN_CAP) break; }
        if (mode != 0) { const int x = q & 7, p = q >> 3; int n0, n1 = -1;
            if (mode == 1) { if (p > 0) n0 = q - 8; else { n0 = q + 56; if (x > 0) n1 = q + 55; } }
            else           { if (p < 7) n0 = q + 8; else { n0 = q - 56; if (x < 7) n1 = q - 55; } }
            sp = 0u; while (xb_ld(qbase + 64 * n0) < ntarget) { __builtin_amdgcn_s_sleep(1); if (++sp > XB_SPIN_CAP) break; }
            if (n1 >= 0) { sp = 0u; while (xb_ld(qbase + 64 * n1) < ntarget) { __builtin_amdgcn_s_sleep(1); if (++sp > XB_SPIN_CAP) break; } } }
        __builtin_amdgcn_fence(__ATOMIC_ACQUIRE, "agent"); asm volatile("s_waitcnt vmcnt(0)" ::: "memory");
    }
    __syncthreads();
}
#define MKBAR(b) XcdBarrier b; { unsigned char* w_ = a.ws; asm volatile("" : "+s"(w_)); b.bar = (unsigned*)(w_ + WS_BAR); b.x = xb_xcc_id(); b.st = (volatile LAS unsigned*)(lds + 131072); b.total = gridDim.x; }
#define GSYNC() do { MKBAR(b_); xcd_barrier(b_); } while (0)
#define QSYNC(mode, ntarget) do { if (gridDim.x == 256) { unsigned char* w_ = a.ws; asm volatile("" : "+s"(w_)); quad_barrier((unsigned*)(w_ + WS_BAR) + XCD_BAR_WORDS, (int)(blockIdx.x & 63u), (mode), (ntarget)); } \
    else { MKBAR(b_); xcd_barrier(b_); } } while (0)
#define LSYNC() QSYNC(0, 0u)
__global__ void __launch_bounds__(512, 2) mk_fwd(Args a) {
    extern __shared__ __attribute__((aligned(16))) unsigned char lds_raw[];
    LAS unsigned char* lds = (LAS unsigned char*)lds_raw;
    cg::grid_group grid = cg::this_grid();
    float* rowss = (float*)(a.ws + WS_ROWSS);
    bf16* XB = (bf16*)(a.ws + WS_XB); bf16* ACT = (bf16*)(a.ws + WS_ACT); bf16* Zb = (bf16*)(a.ws + WS_Z); bf16* MIX = (bf16*)(a.ws + WS_MIX);
    const int G = gridDim.x, cb = blockIdx.x;

    if (threadIdx.x < 4) ((LAS unsigned*)(lds + 131072))[threadIdx.x] = 0u;
    __syncthreads();
    (void)xcd_barrier_post((unsigned*)(a.ws + WS_BAR), (volatile LAS unsigned*)(lds + 131072), gridDim.x);
    if (threadIdx.x == 0) __hip_atomic_fetch_or((unsigned*)(a.ws + WS_BAR) + XCD_BAR_WORDS + 64 * (blockIdx.x & 63u) + 1, 1u << xb_xcc_id(), __ATOMIC_RELAXED, __HIP_MEMORY_SCOPE_AGENT);
    if (a.ws == nullptr) grid.sync();
    p0_prologue(a);
    GSYNC();
#pragma unroll 1
    for (int l = 0; l < 2; ++l) {
        unsigned char* wl = a.ws + WS_W + (size_t)l * SZ_LAYER;
        const int qs0 = (l == 0) ? 0 : 7;
        {
            pg8::Gemm g{XB, (const bf16*)(wl + OFF_GU1), T, 2 * FF, DM}; pg8::StaticOrder S; S.init(T, 2 * FF, G, cb);
            if (l == 0) { CvtRest cv; cv.a = &a; cv.it.on = false; pg8::EpiSwiglu<CvtRest> E{ACT, FF, rowss + (3 * l + 0) * T, cv};
                pg8::gemm_phase<pg8::EpiSwiglu<CvtRest>, pg8::StaticOrder, true, true>(lds, g, S, E); }
            else { pg8::EpiSwiglu<pg8::NoCvt> E{ACT, FF, rowss + (3 * l + 0) * T, pg8::NoCvt{}};
                pg8::gemm_phase<pg8::EpiSwiglu<pg8::NoCvt>, pg8::StaticOrder, true, true>(lds, g, S, E); } }
        if (l == 0) GSYNC(); else LSYNC();
        {
            pg8::Gemm g{ACT, (const bf16*)(wl + OFF_D1), T, DM, FF}; pg8::StaticOrder S; S.init(T, DM, G, cb);
            pg8::EpiResid E{XB, rowss + (3 * l + 1) * T, 0.5f};
            pg8::gemm_phase<pg8::EpiResid, pg8::StaticOrder, true, true>(lds, g, S, E); }
        LSYNC();
        {
            pg8::Gemm g{XB, (const bf16*)(wl + OFF_IN), T, INW, DM}; pg8::StaticOrder S; S.init(T, INW, G, cb);
            pg8::EpiRowScale E{Zb, ZP, rowss + (3 * l + 1) * T};
            pg8::gemm_phase<pg8::EpiRowScale, pg8::StaticOrder, true, true>(lds, g, S, E); }
        QSYNC(1, 4u * (unsigned)(qs0 + 2));
        attn_conv_phase(lds, Zb, MIX, a.in[8] + l * 8, a.in[7] + l * 3 * 512, gridDim.x == 256);
        LSYNC();
        {
            pg8::Gemm g{MIX, (const bf16*)(wl + OFF_OUT), T, DM, DM}; pg8::StaticOrder S; S.init(T, DM, G, cb);
            pg8::EpiResid E{XB, rowss + (3 * l + 2) * T, 1.0f};
            pg8::gemm_phase<pg8::EpiResid, pg8::StaticOrder, true, true>(lds, g, S, E); }
        QSYNC(2, 4u * (unsigned)(qs0 + 3));
        {
            pg8::Gemm g{XB, (const bf16*)(wl + OFF_GU2), T, 2 * FF, DM}; pg8::StaticOrder S; S.init(T, 2 * FF, G, cb);
            pg8::EpiSwiglu<pg8::NoCvt> E{ACT, FF, rowss + (3 * l + 2) * T, pg8::NoCvt{}};
            pg8::gemm_phase<pg8::EpiSwiglu<pg8::NoCvt>, pg8::StaticOrder, true, true>(lds, g, S, E); }
        LSYNC();
        {
            pg8::Gemm g{ACT, (const bf16*)(wl + OFF_D2), T, DM, FF}; pg8::StaticOrder S; S.init(T, DM, G, cb);
            pg8::EpiResid E{XB, rowss + (3 * l + 3) * T, 0.5f};
            pg8::gemm_phase<pg8::EpiResid, pg8::StaticOrder, true, true>(lds, g, S, E); }
        LSYNC();
    }
    final_norm(a);
}

extern "C" void kernel_launch(void* const* d_in, const int* in_sizes, int n_in, void* d_out, int out_size, void* d_ws, size_t ws_size, hipStream_t stream) {
    static int grid_blocks = 0;
    if (!grid_blocks) {
        if (n_in != 15 || out_size != T * DM || ws_size < WS_END) { fprintf(stderr, "kernel_launch: unexpected shapes (n_in %d out %d ws %zu)\n", n_in, out_size, ws_size); grid_blocks = -1; return; }
        int dev = 0, cus = 0, per_cu = 0;
        (void)hipGetDevice(&dev);
        (void)hipDeviceGetAttribute(&cus, hipDeviceAttributeMultiprocessorCount, dev);
        (void)hipFuncSetAttribute((const void*)mk_fwd, hipFuncAttributeMaxDynamicSharedMemorySize, LDS_BYTES);
        (void)hipOccupancyMaxActiveBlocksPerMultiprocessor(&per_cu, (const void*)mk_fwd, 512, LDS_BYTES);
        if (per_cu < 1) per_cu = 1;
        grid_blocks = cus * per_cu;
    }
    if (grid_blocks < 0) return;
    if (hipMemsetAsync((unsigned char*)d_ws + WS_BAR, 0, (XCD_BAR_WORDS + 64 * 64) * 4, stream) != hipSuccess) { fprintf(stderr, "kernel_launch: memset of the barrier words failed\n"); return; }
    Args a{};
    for (int i = 0; i < 15; ++i) a.in[i] = (const float*)d_in[i];
    a.out = (float*)d_out; a.ws = (unsigned char*)d_ws;
    void* args[] = {&a};
    hipError_t e = hipLaunchCooperativeKernel((void*)mk_fwd, dim3(grid_blocks), dim3(512), args, LDS_BYTES, stream);
    if (e != hipSuccess) fprintf(stderr, "cooperative launch failed: %s (grid %d)\n", hipGetErrorString(e), grid_blocks);
}
```
